# Optimizing an MI355X kernel written in HIP

```python
import jax
import jax.numpy as jnp
from jax import lax
import numpy as np

D_MODEL = 1024
BATCH = 4
SEQ = 4096
DEPTH = 4

GRID_W = 64
MEM_LEN = 256
HEAD_DIM = 64
Q_BLOCK = 128
ROPE_THETA = 10000.0
LN_EPS = 1e-5
RMS_EPS = 1e-6
NA_HEADS = 4
NA_ROWS = 8
NA_COLS = 16
GQA_HEADS = 8
GQA_KV_HEADS = 2
GQA_GROUP = GQA_HEADS // GQA_KV_HEADS
MLA_HEADS = 4
MLA_Q_RANK = 256
MLA_KV_RANK = 128
MLA_NOPE = 64
MLA_ROPE = 32
MLA_V = 64
N_BRANCH = 3
A_WIDTH = NA_HEADS * HEAD_DIM
B_WIDTH = GQA_HEADS * HEAD_DIM
C_WIDTH = MLA_HEADS * MLA_V
IN_SPLITS = (A_WIDTH, A_WIDTH, A_WIDTH,
             B_WIDTH, GQA_KV_HEADS * HEAD_DIM, GQA_KV_HEADS * HEAD_DIM,
             MLA_Q_RANK, MLA_KV_RANK, MLA_ROPE,
             N_BRANCH * D_MODEL)
IN_COLS = sum(IN_SPLITS)
MEM_HEADS = 4
MEM_HEAD_DIM = D_MODEL // MEM_HEADS
D_FF = ((8 * D_MODEL // 3 + 127) // 128) * 128
N_EXPERTS = 8
TOP_K = 2
N_DENSE = (DEPTH + 1) // 2
N_MOE = DEPTH // 2
ALPHA = (2 * DEPTH) ** 0.25
BETA = (8 * DEPTH) ** -0.25

kernel_name = 'hybrid_natten_gqa_mla_moe_encoder'


def layer_norm(x, g, b):
    xf = x.astype(jnp.float32)
    mu = jnp.mean(xf, axis=-1, keepdims=True)
    var = jnp.mean(jnp.square(xf - mu), axis=-1, keepdims=True)
    return ((xf - mu) * lax.rsqrt(var + LN_EPS) * g + b).astype(x.dtype)


def rms_norm(x, g):
    xf = x.astype(jnp.float32)
    return (xf * lax.rsqrt(jnp.mean(xf * xf, axis=-1, keepdims=True) + RMS_EPS) * g).astype(x.dtype)


def axial_rope_angles(seq, rot_dim):
    t = jnp.arange(seq)
    row = (t // GRID_W).astype(jnp.float32)
    col = (t % GRID_W).astype(jnp.float32)
    n = rot_dim // 4
    inv_freq = ROPE_THETA ** (-jnp.arange(n, dtype=jnp.float32) / n)
    ang = jnp.concatenate([row[:, None] * inv_freq, col[:, None] * inv_freq], axis=-1)
    return jnp.cos(ang), jnp.sin(ang)


def apply_rope(x, cos, sin):
    half = x.shape[-1] // 2
    xf = x.astype(jnp.float32)
    x1, x2 = xf[..., :half], xf[..., half:]
    c, s = cos[None, :, None, :], sin[None, :, None, :]
    return jnp.concatenate([x1 * c - x2 * s, x2 * c + x1 * s], axis=-1).astype(x.dtype)


def blocked_attention(q, k, v, scale):
    b, s, hkv, g, dk = q.shape
    nb = s // Q_BLOCK
    qb = q.reshape(b, nb, Q_BLOCK, hkv, g, dk).swapaxes(0, 1)

    def attend(q_blk):
        sc = jnp.einsum('bqhgd,bkhd->bhgqk', q_blk, k).astype(jnp.float32) * scale
        p = jax.nn.softmax(sc, axis=-1).astype(v.dtype)
        return jnp.einsum('bhgqk,bkhd->bqhgd', p, v)

    o = lax.map(attend, qb)
    return o.swapaxes(0, 1).reshape(b, s, hkv * g * v.shape[-1])


def neighborhood_attention(q, k, v, rpb):
    b, s, h, d = q.shape
    rows = s // GRID_W
    kr = min(NA_ROWS, rows)
    n_keys = kr * NA_COLS
    r = jnp.arange(rows)
    c = jnp.arange(GRID_W)
    key_r = jnp.clip(r - kr // 2, 0, rows - kr)[:, None] + jnp.arange(kr)
    key_c = jnp.clip(c - NA_COLS // 2, 0, GRID_W - NA_COLS)[:, None] + jnp.arange(NA_COLS)
    idx = (key_r[:, None, :, None] * GRID_W + key_c[None, :, None, :]).reshape(rows, GRID_W, n_keys)
    dr = key_r - r[:, None] + (NA_ROWS - 1)
    dc = key_c - c[:, None] + (NA_COLS - 1)
    bias = rpb[:, dr[:, None, :, None], dc[None, :, None, :]]
    bias = bias.reshape(h, rows, GRID_W, n_keys).transpose(1, 0, 2, 3)
    q_rows = q.reshape(b, rows, GRID_W, h, d).swapaxes(0, 1)
    scale = d ** -0.5

    def attend_row(args):
        q_r, idx_r, bias_r = args
        k_g = k[:, idx_r]
        v_g = v[:, idx_r]
        sc = jnp.einsum('bwhd,bwnhd->bhwn', q_r, k_g).astype(jnp.float32) * scale + bias_r.astype(jnp.float32)
        p = jax.nn.softmax(sc, axis=-1).astype(v.dtype)
        return jnp.einsum('bhwn,bwnhd->bwhd', p, v_g)

    o = lax.map(attend_row, (q_rows, idx, bias))
    return o.swapaxes(0, 1).reshape(b, s, h * d)


def hybrid_mixer(h, w_in, na_rpb, gqa_q_norm, gqa_k_norm, mla_q_norm, mla_kv_norm,
                 mla_w_uq, mla_w_ukv, w_proj_a, w_proj_b, w_proj_c, w_out, rope_b, rope_c):
    b, s, _ = h.shape
    z = h @ w_in
    (a_q, a_k, a_v, b_q, b_k, b_v, c_dq, c_dkv, c_kr, gate_logits) = jnp.split(
        z, np.cumsum(IN_SPLITS)[:-1].tolist(), axis=-1)

    ya = neighborhood_attention(a_q.reshape(b, s, NA_HEADS, HEAD_DIM),
                                a_k.reshape(b, s, NA_HEADS, HEAD_DIM),
                                a_v.reshape(b, s, NA_HEADS, HEAD_DIM), na_rpb)

    cos_b, sin_b = rope_b
    qb = apply_rope(rms_norm(b_q.reshape(b, s, GQA_HEADS, HEAD_DIM), gqa_q_norm), cos_b, sin_b)
    kb = apply_rope(rms_norm(b_k.reshape(b, s, GQA_KV_HEADS, HEAD_DIM), gqa_k_norm), cos_b, sin_b)
    vb = b_v.reshape(b, s, GQA_KV_HEADS, HEAD_DIM)
    yb = blocked_attention(qb.reshape(b, s, GQA_KV_HEADS, GQA_GROUP, HEAD_DIM), kb, vb, HEAD_DIM ** -0.5)

    cos_c, sin_c = rope_c
    qc = (rms_norm(c_dq, mla_q_norm) @ mla_w_uq).reshape(b, s, MLA_HEADS, MLA_NOPE + MLA_ROPE)
    q_nope, q_pe = qc[..., :MLA_NOPE], apply_rope(qc[..., MLA_NOPE:], cos_c, sin_c)
    kvc = (rms_norm(c_dkv, mla_kv_norm) @ mla_w_ukv).reshape(b, s, MLA_HEADS, MLA_NOPE + MLA_V)
    k_nope, vc = kvc[..., :MLA_NOPE], kvc[..., MLA_NOPE:]
    k_pe = apply_rope(c_kr[:, :, None, :], cos_c, sin_c)
    q_full = jnp.concatenate([q_nope, q_pe], axis=-1)[:, :, :, None, :]
    k_full = jnp.concatenate([k_nope, jnp.broadcast_to(k_pe, (b, s, MLA_HEADS, MLA_ROPE))], axis=-1)
    yc = blocked_attention(q_full, k_full, vc, (MLA_NOPE + MLA_ROPE) ** -0.5)

    gates = jax.nn.sigmoid(gate_logits.astype(jnp.float32)).astype(h.dtype).reshape(b, s, N_BRANCH, D_MODEL)
    merged = (gates[:, :, 0] * (ya @ w_proj_a)
              + gates[:, :, 1] * (yb @ w_proj_b)
              + gates[:, :, 2] * (yc @ w_proj_c))
    return merged @ w_out


def memory_cross_attention(h, mem, wq, wkv, wo):
    b, s, _ = h.shape
    m = mem.shape[1]
    q = (h @ wq).reshape(b, s, MEM_HEADS, MEM_HEAD_DIM)
    kv = (mem @ wkv).reshape(b, m, 2, MEM_HEADS, MEM_HEAD_DIM)
    k, v = kv[:, :, 0], kv[:, :, 1]
    sc = jnp.einsum('bqhd,bkhd->bhqk', q, k).astype(jnp.float32) * (MEM_HEAD_DIM ** -0.5)
    p = jax.nn.softmax(sc, axis=-1).astype(v.dtype)
    o = jnp.einsum('bhqk,bkhd->bqhd', p, v).reshape(b, s, D_MODEL)
    return o @ wo


def swiglu(t, w_gu, w_down):
    a, g = jnp.split(t @ w_gu, 2, axis=-1)
    return (jax.nn.silu(a) * g) @ w_down


def moe_swiglu(h, w_router, w_gu, w_down):
    b, s, d = h.shape
    t = h.reshape(b * s, d)
    logits = (t @ w_router).astype(jnp.float32)
    top_logit, top_idx = lax.top_k(logits, TOP_K)
    top_w = jax.nn.softmax(top_logit, axis=-1)
    gate = jnp.einsum('tk,tke->te', top_w,
                      jax.nn.one_hot(top_idx, N_EXPERTS, dtype=jnp.float32)).astype(h.dtype)
    out = jnp.zeros_like(t)
    for e in range(N_EXPERTS):
        out = out + gate[:, e:e + 1] * swiglu(t, w_gu[e], w_down[e])
    return out.reshape(b, s, d)


def setup_inputs(seed: int = 0) -> dict:
    key = jax.random.key(seed)
    k = jax.random.split(key, 26)

    def nrm(kk, shape, std):
        return jax.random.normal(kk, shape, jnp.float32) * std

    def gain(kk, shape):
        return 1.0 + 0.05 * jax.random.normal(kk, shape, jnp.float32)

    return {
        'x': nrm(k[0], (BATCH, SEQ, D_MODEL), 1.0),
        'mem': nrm(k[1], (BATCH, MEM_LEN, D_MODEL), 1.0),
        'emb_ln_g': gain(k[2], (D_MODEL,)),
        'emb_ln_b': nrm(k[3], (D_MODEL,), 0.02),
        'w_in': nrm(k[4], (DEPTH, D_MODEL, IN_COLS), D_MODEL ** -0.5),
        'na_rpb': nrm(k[5], (DEPTH, NA_HEADS, 2 * NA_ROWS - 1, 2 * NA_COLS - 1), 0.1),
        'gqa_q_norm': gain(k[6], (DEPTH, HEAD_DIM)),
        'gqa_k_norm': gain(k[7], (DEPTH, HEAD_DIM)),
        'mla_q_norm': gain(k[8], (DEPTH, MLA_Q_RANK)),
        'mla_kv_norm': gain(k[9], (DEPTH, MLA_KV_RANK)),
        'mla_w_uq': nrm(k[10], (DEPTH, MLA_Q_RANK, MLA_HEADS * (MLA_NOPE + MLA_ROPE)), MLA_Q_RANK ** -0.5),
        'mla_w_ukv': nrm(k[11], (DEPTH, MLA_KV_RANK, MLA_HEADS * (MLA_NOPE + MLA_V)), MLA_KV_RANK ** -0.5),
        'w_proj_a': nrm(k[12], (DEPTH, A_WIDTH, D_MODEL), A_WIDTH ** -0.5),
        'w_proj_b': nrm(k[13], (DEPTH, B_WIDTH, D_MODEL), B_WIDTH ** -0.5),
        'w_proj_c': nrm(k[14], (DEPTH, C_WIDTH, D_MODEL), C_WIDTH ** -0.5),
        'w_out': nrm(k[15], (DEPTH, D_MODEL, D_MODEL), BETA * D_MODEL ** -0.5),
        'mem_wq': nrm(k[16], (DEPTH, D_MODEL, D_MODEL), D_MODEL ** -0.5),
        'mem_wkv': nrm(k[17], (DEPTH, D_MODEL, 2 * D_MODEL), D_MODEL ** -0.5),
        'mem_wo': nrm(k[18], (DEPTH, D_MODEL, D_MODEL), BETA * D_MODEL ** -0.5),
        'ln_g': gain(k[19], (DEPTH, 3, D_MODEL)),
        'ln_b': nrm(k[20], (DEPTH, 3, D_MODEL), 0.02),
        'ffn_w_gu': nrm(k[21], (N_DENSE, D_MODEL, 2 * D_FF), D_MODEL ** -0.5),
        'ffn_w_down': nrm(k[22], (N_DENSE, D_FF, D_MODEL), BETA * D_FF ** -0.5),
        'moe_router': nrm(k[23], (N_MOE, D_MODEL, N_EXPERTS), D_MODEL ** -0.5),
        'moe_w_gu': nrm(k[24], (N_MOE, N_EXPERTS, D_MODEL, 2 * D_FF), D_MODEL ** -0.5),
        'moe_w_down': nrm(k[25], (N_MOE, N_EXPERTS, D_FF, D_MODEL), BETA * D_FF ** -0.5),
    }


def reference(x, mem, emb_ln_g, emb_ln_b, w_in, na_rpb, gqa_q_norm, gqa_k_norm, mla_q_norm,
              mla_kv_norm, mla_w_uq, mla_w_ukv, w_proj_a, w_proj_b, w_proj_c, w_out,
              mem_wq, mem_wkv, mem_wo, ln_g, ln_b, ffn_w_gu, ffn_w_down,
              moe_router, moe_w_gu, moe_w_down):
    s = x.shape[1]
    rope_b = axial_rope_angles(s, HEAD_DIM)
    rope_c = axial_rope_angles(s, MLA_ROPE)
    h = layer_norm(x, emb_ln_g, emb_ln_b)
    for l in range(DEPTH):
        mix = hybrid_mixer(h, w_in[l], na_rpb[l], gqa_q_norm[l], gqa_k_norm[l], mla_q_norm[l],
                           mla_kv_norm[l], mla_w_uq[l], mla_w_ukv[l], w_proj_a[l], w_proj_b[l],
                           w_proj_c[l], w_out[l], rope_b, rope_c)
        h = layer_norm(ALPHA * h + mix, ln_g[l, 0], ln_b[l, 0])
        xa = memory_cross_attention(h, mem, mem_wq[l], mem_wkv[l], mem_wo[l])
        h = layer_norm(ALPHA * h + xa, ln_g[l, 1], ln_b[l, 1])
        if l % 2 == 0:
            f = swiglu(h, ffn_w_gu[l // 2], ffn_w_down[l // 2])
        else:
            f = moe_swiglu(h, moe_router[l // 2], moe_w_gu[l // 2], moe_w_down[l // 2])
        h = layer_norm(ALPHA * h + f, ln_g[l, 2], ln_b[l, 2])
    return h
```

```cpp
#include <hip/hip_runtime.h>
#include <cstdio>
#include <cstdint>
#include <cmath>

typedef unsigned short bf16;
constexpr int T = 16384, D = 1024, SEQ = 4096, NBATCH = 4, DEPTH = 4, INC = 5024, DFF = 2816, NE = 8, MEMLEN = 256;
constexpr int NSLOT = 2 * T + 2048;
constexpr float LOG2E = 1.4426950408889634f;
constexpr float C2_A = 0.125f * LOG2E, C2_B = 0.125f * LOG2E, C2_C = 0.10206207261596577f * LOG2E, C2_X = 0.0625f * LOG2E;
constexpr float ALPHA = 1.681792830507429f;

__host__ __device__ __forceinline__ unsigned f2bf(float f) { unsigned u = __builtin_bit_cast(unsigned, f); return (u + 0x7fffu + ((u >> 16) & 1u)) >> 16; }
__host__ __device__ __forceinline__ float bf2f(bf16 b) { return __builtin_bit_cast(float, (unsigned)b << 16); }

constexpr size_t MiB = 1u << 20;
constexpr size_t WS_CTL = 0, CTL_ZERO_BYTES = 1 * MiB;
constexpr size_t WS_TAB = 1 * MiB;
constexpr size_t WS_ROUTE = 2 * MiB;
constexpr size_t WS_SSQQ = 3 * MiB, WS_SSQKV = 3 * MiB + 256 * 1024;
constexpr size_t WS_KPE = 4 * MiB, WS_MEMB = 5 * MiB, WS_MEMK = 7 * MiB, WS_MEMVT = 15 * MiB;
constexpr size_t WS_HF = 24 * MiB, WS_HB = 88 * MiB;
constexpr size_t WS_AQ = 120 * MiB, WS_AK = 128 * MiB, WS_AV = 136 * MiB, WS_BQ = 144 * MiB, WS_BK = 160 * MiB, WS_BV = 164 * MiB;
constexpr size_t WS_CDQ = 168 * MiB, WS_CDKV = 176 * MiB, WS_CQ = 180 * MiB, WS_CK = 192 * MiB, WS_CV = 200 * MiB;
constexpr size_t WS_YA = 208 * MiB, WS_YB = 216 * MiB, WS_YC = 232 * MiB, WS_GATES = 240 * MiB, WS_MERGED = 336 * MiB;
constexpr size_t WS_XQ = 368 * MiB, WS_XO = 400 * MiB;
constexpr size_t WS_ACT = 432 * MiB, WS_Y = 620 * MiB, WS_F = 760 * MiB;
constexpr size_t WS_ZF = 432 * MiB;
constexpr size_t WS_WEIGHTS = 832 * MiB;
constexpr size_t WS_END = 1232 * MiB;
#define FASTMASK 0x1ff
namespace nv {

__device__ __forceinline__ float wave_sum(float v) {
#pragma unroll
    for (int o = 1; o < 64; o <<= 1) v += __shfl_xor(v, o);
    return v;
}

__global__ void k_rope_tab(float* cosb, float* sinb, float* cosc, float* sinc) {
    const int i = blockIdx.x * blockDim.x + threadIdx.x;
    if (i < 64 * 16) { const int v = i / 16, j = i % 16; const float f = powf(10000.0f, -(float)j / 16.0f); const float a = (float)v * f; cosb[i] = cosf(a); sinb[i] = sinf(a); }
    if (i < 64 * 8) { const int v = i / 8, j = i % 8; const float f = powf(10000.0f, -(float)j / 8.0f); const float a = (float)v * f; cosc[i] = cosf(a); sinc[i] = sinf(a); }
}

__global__ void __launch_bounds__(256) k_ln(const float* res, float alpha, const float* add, const float* g, const float* b, float* outf, float* outf2, bf16* outb) {
    const int row = blockIdx.x * 4 + (threadIdx.x >> 6), lane = threadIdx.x & 63;
    float v[16]; float s = 0.f;
#pragma unroll
    for (int j = 0; j < 16; ++j) { const int c = lane + 64 * j; float x = 0.f; if (res) x = alpha * res[(size_t)row * D + c]; if (add) x += add[(size_t)row * D + c]; v[j] = x; s += x; }
    const float mean = wave_sum(s) * (1.f / D); float q = 0.f;
#pragma unroll
    for (int j = 0; j < 16; ++j) { v[j] -= mean; q += v[j] * v[j]; }
    const float rstd = rsqrtf(wave_sum(q) * (1.f / D) + 1e-5f);
#pragma unroll
    for (int j = 0; j < 16; ++j) { const int c = lane + 64 * j; const float o = v[j] * rstd * g[c] + b[c]; outf[(size_t)row * D + c] = o; if (outf2) outf2[(size_t)row * D + c] = o; outb[(size_t)row * D + c] = (bf16)f2bf(o); }
}

struct NG { const bf16* A; int lda; const int* rowidx; const int* segbase; const int* segcnt; const float* W; size_t wstride; int ldw; float* C; bf16* Cb; int ldc; int M, N, K; };
template <int MODE> __global__ void __launch_bounds__(256) k_gemm(NG p) {
    __shared__ float As[16][65]; __shared__ float Ws[16][64]; __shared__ float Ws2[MODE ? 16 : 1][64];
    const int tx = threadIdx.x & 15, ty = threadIdx.x >> 4, m0 = blockIdx.y * 64, n0 = blockIdx.x * 64;
    const float* W = p.W; int e = 0, lim = p.M;
    if (p.segbase) { while (e < NE - 1 && m0 >= p.segbase[e + 1]) ++e; if (m0 >= p.segbase[NE]) return; W += (size_t)e * p.wstride; lim = p.segbase[e] + p.segcnt[e]; if (m0 >= lim) return; }
    float acc[4][4] = {}, acc2[4][4] = {};
    const int lr = threadIdx.x >> 2, lc = (threadIdx.x & 3) * 4;
    int arow = m0 + lr; if (p.segbase && arow >= lim) arow = -1; size_t aoff;
    if (p.rowidx) aoff = (size_t)(arow >= 0 ? p.rowidx[arow] : 0) * p.lda; else aoff = (size_t)(arow >= 0 ? arow : 0) * p.lda;
    const int wr = threadIdx.x >> 4, wc = (threadIdx.x & 15) * 4;
    for (int k0 = 0; k0 < p.K; k0 += 16) {
#pragma unroll
        for (int i = 0; i < 4; ++i) As[lc + i][lr] = bf2f(p.A[aoff + k0 + lc + i]);
#pragma unroll
        for (int i = 0; i < 4; ++i) { const bool okn = (n0 + wc + i) < p.N; Ws[wr][wc + i] = okn ? W[(size_t)(k0 + wr) * p.ldw + n0 + wc + i] : 0.f; if (MODE) Ws2[wr][wc + i] = W[(size_t)(k0 + wr) * p.ldw + p.N + n0 + wc + i]; }
        __syncthreads();
#pragma unroll
        for (int k = 0; k < 16; ++k) {
            float a[4], w[4], w2[4];
#pragma unroll
            for (int i = 0; i < 4; ++i) { a[i] = As[k][ty * 4 + i]; w[i] = Ws[k][tx * 4 + i]; if (MODE) w2[i] = Ws2[k][tx * 4 + i]; }
#pragma unroll
            for (int i = 0; i < 4; ++i)
#pragma unroll
                for (int j = 0; j < 4; ++j) { acc[i][j] += a[i] * w[j]; if (MODE) acc2[i][j] += a[i] * w2[j]; }
        }
        __syncthreads();
    }
#pragma unroll
    for (int i = 0; i < 4; ++i)
#pragma unroll
        for (int j = 0; j < 4; ++j) { if (n0 + tx * 4 + j >= p.N) continue; const size_t o = (size_t)(m0 + ty * 4 + i) * p.ldc + n0 + tx * 4 + j;
            if (MODE) { const float a = acc[i][j]; p.Cb[o] = (bf16)f2bf(a / (1.f + expf(-a)) * acc2[i][j]); } else p.C[o] = acc[i][j]; }
}

struct InEpi { const float* z; bf16 *aq, *ak, *av, *bq, *bk, *bv, *cdq, *cdkv, *kpe, *gates; float *ssq_q, *ssq_kv; const float *gqn, *gkn, *mqn, *mkvn; const float *cosb, *sinb, *cosc, *sinc; };
__global__ void __launch_bounds__(256) k_inproj_epi(InEpi p) {
    __shared__ float red[8];
    const int t = blockIdx.x, tid = threadIdx.x, lane = tid & 63, w = tid >> 6;
    const float* z = p.z + (size_t)t * INC; const int pos = t % SEQ, prow = pos / 64, pcol = pos % 64;
    p.aq[(size_t)t * 256 + tid] = (bf16)f2bf(z[tid] * C2_A); p.ak[(size_t)t * 256 + tid] = (bf16)f2bf(z[256 + tid]); p.av[(size_t)t * 256 + tid] = (bf16)f2bf(z[512 + tid]);
    const int i32 = lane & 31, j16 = i32 & 15, vv = (i32 < 16) ? prow : pcol; const float cb = p.cosb[vv * 16 + j16], sb = p.sinb[vv * 16 + j16];
    for (int hh = 0; hh < 2; ++hh) { const int h = w * 2 + hh; const float v = z[768 + h * 64 + lane]; const float r = rsqrtf(wave_sum(v * v) * (1.f / 64.f) + 1e-6f);
        const float nvv = v * r * p.gqn[lane], pr = __shfl_xor(nvv, 32); const float o = (lane < 32) ? nvv * cb - pr * sb : nvv * cb + pr * sb;
        p.bq[(size_t)t * 512 + h * 64 + lane] = (bf16)f2bf(o * C2_B); }
    if (w < 2) { const int h = w; const float v = z[1280 + h * 64 + lane]; const float r = rsqrtf(wave_sum(v * v) * (1.f / 64.f) + 1e-6f);
        const float nvv = v * r * p.gkn[lane], pr = __shfl_xor(nvv, 32); const float o = (lane < 32) ? nvv * cb - pr * sb : nvv * cb + pr * sb;
        p.bk[(size_t)t * 128 + h * 64 + lane] = (bf16)f2bf(o); }
    if (tid < 128) p.bv[(size_t)t * 128 + tid] = (bf16)f2bf(z[1408 + tid]);
    { const float v = z[1536 + tid]; p.cdq[(size_t)t * 256 + tid] = (bf16)f2bf(v * p.mqn[tid]); const float s = wave_sum(v * v); if (lane == 0) red[w] = s; }
    { float v = 0.f; if (tid < 128) { v = z[1792 + tid]; p.cdkv[(size_t)t * 128 + tid] = (bf16)f2bf(v * p.mkvn[tid]); } const float s = wave_sum(v * v); if (lane == 0) red[4 + w] = s; }
    __syncthreads();
    if (tid < 4) { p.ssq_q[(size_t)t * 4 + tid] = tid == 0 ? (red[0] + red[1] + red[2] + red[3]) : 0.f; p.ssq_kv[(size_t)t * 4 + tid] = tid == 0 ? (red[4] + red[5]) : 0.f; }
    if (w == 0) { const int i = lane & 31; const float v = z[1920 + i]; const int j8 = i & 7, v2 = ((i & 15) < 8) ? prow : pcol; const float c = p.cosc[v2 * 8 + j8], s = p.sinc[v2 * 8 + j8];
        const float pr = __shfl_xor(v, 16); const float o = (i < 16) ? v * c - pr * s : v * c + pr * s; if (lane < 32) p.kpe[(size_t)t * 32 + i] = (bf16)f2bf(o); }
    for (int i = tid; i < 3072; i += 256) { const float v = z[1952 + i]; p.gates[(size_t)t * 3072 + i] = (bf16)f2bf(1.f / (1.f + expf(-v))); }
}

struct MlaEpi { const float *qcf, *kvcf, *ssq_q, *ssq_kv; bf16 *cq, *ck, *cv; const float *cosc, *sinc; };
__global__ void __launch_bounds__(256) k_mla_epi(MlaEpi p) {
    const int t = blockIdx.x, tid = threadIdx.x; const int pos = t % SEQ, prow = pos / 64, pcol = pos % 64;
    const float rq = rsqrtf((p.ssq_q[t * 4] + p.ssq_q[t * 4 + 1] + p.ssq_q[t * 4 + 2] + p.ssq_q[t * 4 + 3]) * (1.f / 256.f) + 1e-6f);
    const float rk = rsqrtf((p.ssq_kv[t * 4] + p.ssq_kv[t * 4 + 1] + p.ssq_kv[t * 4 + 2] + p.ssq_kv[t * 4 + 3]) * (1.f / 128.f) + 1e-6f);
    const float* q = p.qcf + (size_t)t * 384; const float* kv = p.kvcf + (size_t)t * 512;
    for (int i = tid; i < 384; i += 256) { const int h = i / 96, d = i % 96; float o;
        if (d < 64) o = q[i] * rq; else { const int j = d - 64, jj = j & 15, j8 = jj & 7, v2 = (jj < 8) ? prow : pcol; const float c = p.cosc[v2 * 8 + j8], s = p.sinc[v2 * 8 + j8];
            const float x1 = q[h * 96 + 64 + jj] * rq, x2 = q[h * 96 + 80 + jj] * rq; o = (j < 16) ? x1 * c - x2 * s : x2 * c + x1 * s; }
        p.cq[(size_t)t * 384 + i] = (bf16)f2bf(o * C2_C); }
    { const int h = tid / 64, d = tid % 64; p.ck[(size_t)t * 256 + tid] = (bf16)f2bf(kv[h * 128 + d] * rk); p.cv[(size_t)t * 256 + tid] = (bf16)f2bf(kv[h * 128 + 64 + d] * rk); }
}

template <int DK1, int DK2, int DV, int NH, int GRP> __global__ void __launch_bounds__(256) k_attn(const bf16* Q, const bf16* K1, const bf16* K2, const bf16* V, bf16* O) {
    constexpr int DK = DK1 + DK2, NKV = NH / GRP;
    const int qi = blockIdx.x * 256 + threadIdx.x, h = blockIdx.y, b = blockIdx.z, hk = h / GRP;
    const size_t trow = (size_t)b * SEQ + qi;
    float q[DK], o[DV];
#pragma unroll
    for (int d = 0; d < DK; ++d) q[d] = bf2f(Q[(trow * NH + h) * DK + d]);
#pragma unroll
    for (int d = 0; d < DV; ++d) o[d] = 0.f;
    float m = -INFINITY, l = 0.f;
    for (int k = 0; k < SEQ; ++k) { const size_t kr = (size_t)b * SEQ + k; const bf16* kp = K1 + (kr * NKV + hk) * DK1; float s = 0.f;
#pragma unroll
        for (int d = 0; d < DK1; ++d) s += q[d] * bf2f(kp[d]);
        if (DK2) { const bf16* kp2 = K2 + kr * DK2;
#pragma unroll
            for (int d = 0; d < DK2; ++d) s += q[DK1 + d] * bf2f(kp2[d]); }
        const float mn = fmaxf(m, s), al = exp2f(m - mn), pp = exp2f(s - mn); l = l * al + pp; m = mn; const bf16* vp = V + (kr * NKV + hk) * DV;
#pragma unroll
        for (int d = 0; d < DV; ++d) o[d] = o[d] * al + pp * bf2f(vp[d]); }
    const float il = 1.f / l;
#pragma unroll
    for (int d = 0; d < DV; ++d) O[(trow * NH + h) * DV + d] = (bf16)f2bf(o[d] * il);
}

__global__ void __launch_bounds__(256) k_natten(const bf16* Q, const bf16* K, const bf16* V, const float* rpb, bf16* O) {
    const int qi = blockIdx.x * 256 + threadIdx.x, h = blockIdx.y, b = blockIdx.z; const size_t trow = (size_t)b * SEQ + qi;
    const int r = qi / 64, c = qi % 64; int kr0 = r - 4; kr0 = kr0 < 0 ? 0 : (kr0 > 56 ? 56 : kr0); int kc0 = c - 8; kc0 = kc0 < 0 ? 0 : (kc0 > 48 ? 48 : kc0);
    float q[64], o[64];
#pragma unroll
    for (int d = 0; d < 64; ++d) { q[d] = bf2f(Q[(trow * 4 + h) * 64 + d]); o[d] = 0.f; }
    float m = -INFINITY, l = 0.f;
    for (int i = 0; i < 8; ++i) for (int j = 0; j < 16; ++j) { const int kr = kr0 + i, kc = kc0 + j; const size_t krow = (size_t)b * SEQ + kr * 64 + kc; const bf16* kp = K + (krow * 4 + h) * 64; float s = 0.f;
#pragma unroll
        for (int d = 0; d < 64; ++d) s += q[d] * bf2f(kp[d]);
        s += rpb[(h * 15 + (kr - r + 7)) * 31 + (kc - c + 15)] * LOG2E;
        const float mn = fmaxf(m, s), al = exp2f(m - mn), pp = exp2f(s - mn); l = l * al + pp; m = mn; const bf16* vp = V + (krow * 4 + h) * 64;
#pragma unroll
        for (int d = 0; d < 64; ++d) o[d] = o[d] * al + pp * bf2f(vp[d]); }
    const float il = 1.f / l;
#pragma unroll
    for (int d = 0; d < 64; ++d) O[(trow * 4 + h) * 64 + d] = (bf16)f2bf(o[d] * il);
}

__global__ void __launch_bounds__(256) k_merge(const float* pa, const float* pb, const float* pc, const bf16* gates, bf16* merged) {
    const size_t i = (size_t)blockIdx.x * 256 + threadIdx.x; const size_t t = i / D, n = i % D; const bf16* g = gates + t * 3072;
    merged[i] = (bf16)f2bf(bf2f(g[n]) * pa[i] + bf2f(g[D + n]) * pb[i] + bf2f(g[2 * D + n]) * pc[i]);
}
__global__ void __launch_bounds__(256) k_scale_bf16(const float* in, float s, bf16* out) { const size_t i = (size_t)blockIdx.x * 256 + threadIdx.x; out[i] = (bf16)f2bf(in[i] * s); }
__global__ void __launch_bounds__(256) k_cvt_bf16(const float* in, bf16* out) { const size_t i = (size_t)blockIdx.x * 256 + threadIdx.x; out[i] = (bf16)f2bf(in[i]); }
__global__ void __launch_bounds__(256) k_memkv_epi(const float* scr, bf16* memk, bf16* memvT) {
    const int i = blockIdx.x * 256 + threadIdx.x; const int r = i / 1024, c = i % 1024;
    memk[(size_t)r * 1024 + c] = (bf16)f2bf(scr[(size_t)r * 2048 + c]); memvT[(size_t)c * 1024 + r] = (bf16)f2bf(scr[(size_t)r * 2048 + 1024 + c]);
}
__global__ void __launch_bounds__(256) k_xattn_s(const bf16* xq, const bf16* memk, float* S) {
    const int key = threadIdx.x, h = blockIdx.y, t = blockIdx.x, b = t / SEQ; const bf16* q = xq + (size_t)t * D + h * 256; const bf16* k = memk + (size_t)(b * 256 + key) * D + h * 256; float s = 0.f;
    for (int d = 0; d < 256; ++d) s += bf2f(q[d]) * bf2f(k[d]);
    S[((size_t)t * 4 + h) * 256 + key] = s;
}
__global__ void __launch_bounds__(256) k_xattn_o(const float* S, const bf16* memvT, bf16* xo) {
    const int dv = threadIdx.x, h = blockIdx.y, t = blockIdx.x, b = t / SEQ; const float* s = S + ((size_t)t * 4 + h) * 256; float m = -INFINITY;
    for (int k = 0; k < 256; ++k) m = fmaxf(m, s[k]);
    float l = 0.f, o = 0.f; const bf16* v = memvT + (size_t)(h * 256 + dv) * 1024 + b * 256;
    for (int k = 0; k < 256; ++k) { const float pp = exp2f(s[k] - m); l += pp; o += pp * bf2f(v[k]); }
    xo[(size_t)t * D + h * 256 + dv] = (bf16)f2bf(o / l);
}
__global__ void __launch_bounds__(256) k_router(const float* hf, const float* wr, int* re, float* rw) {
    const int t = blockIdx.x * 4 + (threadIdx.x >> 6), lane = threadIdx.x & 63; float acc[NE];
#pragma unroll
    for (int e = 0; e < NE; ++e) acc[e] = 0.f;
    for (int j = 0; j < 16; ++j) { const int c = lane + 64 * j; const float x = hf[(size_t)t * D + c];
#pragma unroll
        for (int e = 0; e < NE; ++e) acc[e] += x * wr[c * NE + e]; }
#pragma unroll
    for (int e = 0; e < NE; ++e) acc[e] = wave_sum(acc[e]);
    if (lane == 0) { int e0 = 0; float l0 = acc[0];
#pragma unroll
        for (int e = 1; e < NE; ++e) if (acc[e] > l0) { l0 = acc[e]; e0 = e; }
        int e1 = -1; float l1 = -INFINITY;
#pragma unroll
        for (int e = 0; e < NE; ++e) if (e != e0 && acc[e] > l1) { l1 = acc[e]; e1 = e; }
        const float p1 = expf(l1 - l0), w0 = 1.f / (1.f + p1), w1 = p1 / (1.f + p1);
        re[t * 2] = e0; re[t * 2 + 1] = e1; rw[t * 2] = w0; rw[t * 2 + 1] = w1; }
}
__global__ void __launch_bounds__(64) k_moe_count(const int* re, int* cnt) {
    const int blk = blockIdx.x, lane = threadIdx.x, t = blk * 64 + lane; const int e0 = re[t * 2], e1 = re[t * 2 + 1];
    for (int e = 0; e < NE; ++e) { const unsigned long long mk = __ballot(e0 == e || e1 == e); if (lane == 0) cnt[blk * NE + e] = __popcll(mk); }
}
__global__ void __launch_bounds__(64) k_moe_assign(const int* re, const int* cnt, int* segbase, int* segcnt, int* list, int* tslot) {
    const int blk = blockIdx.x, lane = threadIdx.x, t = blk * 64 + lane;
    const int e0 = re[t * 2], e1 = re[t * 2 + 1]; int base = 0;
#pragma unroll
    for (int e = 0; e < NE; ++e) { int s = 0, sb = 0; for (int b2 = lane; b2 < T / 64; b2 += 64) { const int c = cnt[b2 * NE + e]; s += c; if (b2 < blk) sb += c; }
#pragma unroll
        for (int o = 1; o < 64; o <<= 1) { s += __shfl_xor(s, o); sb += __shfl_xor(sb, o); }
        if (blk == 0 && lane == 0) { segbase[e] = base; segcnt[e] = s; }
        const unsigned long long mk = __ballot(e0 == e || e1 == e); const int rank = __popcll(mk & ((1ull << lane) - 1ull));
        if (e0 == e || e1 == e) { const int slot = base + sb + rank; list[slot] = t; tslot[t * 2 + (e1 == e ? 1 : 0)] = slot; }
        base += (s + 255) & ~255; }
    if (blk == 0 && lane == 0) segbase[NE] = base;
}
__global__ void __launch_bounds__(256) k_moe_combine(const float* y, const int* tslot, const float* rw, float* f) {
    const size_t i = (size_t)blockIdx.x * 256 + threadIdx.x; const size_t t = i / D, n = i % D;
    f[i] = rw[t * 2] * y[(size_t)tslot[t * 2] * D + n] + rw[t * 2 + 1] * y[(size_t)tslot[t * 2 + 1] * D + n];
}
}
#define GAS __attribute__((address_space(1)))
#define LAS __attribute__((address_space(3)))
typedef unsigned v4u __attribute__((ext_vector_type(4)));
typedef unsigned v2u __attribute__((ext_vector_type(2)));
typedef float f32x4 __attribute__((ext_vector_type(4)));
typedef float f32x2 __attribute__((ext_vector_type(2)));
typedef float f32x16 __attribute__((ext_vector_type(16)));
typedef short bf16x8 __attribute__((ext_vector_type(8)));
typedef short s16x4 __attribute__((ext_vector_type(4)));
typedef GAS unsigned gu32;
#define RLX_AGENT __ATOMIC_RELAXED, __HIP_MEMORY_SCOPE_AGENT
#define LDS_WAIT() asm volatile("s_waitcnt lgkmcnt(0)" ::: "memory")
#define VM_WAIT() asm volatile("s_waitcnt vmcnt(0)" ::: "memory")
constexpr int NWAVES = 8;
constexpr int RING_BYTES = 131072;
constexpr int EPI_OFF = RING_BYTES;
constexpr int EPI_BYTES = 24576;
constexpr int MISC_OFF = EPI_OFF + EPI_BYTES;
constexpr int LDS_BYTES = MISC_OFF + 256;

#define XB_TMO      128
#define XB_XCNT(j)  (256  + 64 * (j))
#define XB_XSUB(j)  (1280 + 64 * (j))
#define XB_XGEN(j)  (2304 + 64 * (j))
#define XB_TOP      3328
#define XB_TOPGEN   3392
#define XCD_BAR_WORDS 3456
#define XB_SPIN_CAP (1u << 18)

__device__ __forceinline__ unsigned xb_ld(unsigned* p)              { return __hip_atomic_load(p, __ATOMIC_RELAXED, __HIP_MEMORY_SCOPE_AGENT); }
__device__ __forceinline__ unsigned xb_add(unsigned* p, unsigned v) { return __hip_atomic_fetch_add(p, v, __ATOMIC_RELAXED, __HIP_MEMORY_SCOPE_AGENT); }
__device__ __forceinline__ unsigned xb_xcc_id() { return (unsigned)__builtin_amdgcn_s_getreg((3 << 11) | 20) & 0xFu; }
#define XB_SPIN(cond, bar) do { unsigned _sp = 0; while (cond) { __builtin_amdgcn_s_sleep(1); \
    if ((++_sp & 255u) == 0u) { if (xb_ld(&(bar)[XB_TMO])) break; if (_sp > XB_SPIN_CAP) { atomicAdd(&(bar)[XB_TMO], 1u); break; } } } } while (0)

struct XcdBarrier {
    unsigned* bar; unsigned x;
    volatile LAS unsigned* st;
};

__device__ __forceinline__ XcdBarrier xcd_barrier_post(unsigned* bar, volatile LAS unsigned* st) {
    XcdBarrier b; b.bar = bar; b.x = xb_xcc_id(); b.st = st;
    if (threadIdx.x == 0) (void)xb_add(&bar[XB_XCNT(b.x)], 1u);
    return b;
}
__device__ __forceinline__ void xcd_barrier_complete(unsigned* bar, unsigned x, unsigned& nloc, unsigned& nx) {
    const unsigned G = gridDim.x * gridDim.y * gridDim.z;
    unsigned sum, cnt, mine, sp = 0u;
    for (;;) {
        sum = 0u; cnt = 0u; mine = 0u;
#pragma unroll
        for (unsigned j = 0; j < 16; ++j) { const unsigned c = xb_ld(&bar[XB_XCNT(j)]); sum += c; cnt += (c > 0u) ? 1u : 0u; mine = (j == x) ? c : mine; }
        if (sum == G) break;
        __builtin_amdgcn_s_sleep(1);
        if ((++sp & 255u) == 0u) { if (xb_ld(&bar[XB_TMO])) break; if (sp > XB_SPIN_CAP) { atomicAdd(&bar[XB_TMO], 1u); break; } }
    }
    nloc = mine > 0u ? mine : 1u; nx = cnt > 0u ? cnt : 1u;
}

__device__ __forceinline__ void xcd_barrier(const XcdBarrier& b) {
    asm volatile("s_waitcnt vmcnt(0)" ::: "memory");
    __syncthreads();
    if (threadIdx.x == 0) {
        unsigned* bar = b.bar;
        __builtin_amdgcn_s_waitcnt(0);
        unsigned nloc = b.st[0], nx = b.st[1];
        if (nloc == 0u) { xcd_barrier_complete(bar, b.x, nloc, nx); b.st[0] = nloc; b.st[1] = nx; }
        const unsigned old = xb_add(&bar[XB_XSUB(b.x)], 1u);
        const unsigned gen = old / nloc;
        if (old + 1u == (gen + 1u) * nloc) {
            __builtin_amdgcn_fence(__ATOMIC_RELEASE, "agent");
            asm volatile("s_waitcnt vmcnt(0)" ::: "memory");
            const unsigned og = xb_add(&bar[XB_TOP], 1u);
            const unsigned tg = og / nx;
            if (og + 1u == (tg + 1u) * nx) xb_add(&bar[XB_TOPGEN], 1u);
            else XB_SPIN(xb_ld(&bar[XB_TOPGEN]) == tg, bar);
            __builtin_amdgcn_fence(__ATOMIC_ACQUIRE, "agent");
            xb_add(&bar[XB_XGEN(b.x)], 1u);
            asm volatile("s_waitcnt vmcnt(0)" ::: "memory");
        } else {
            XB_SPIN(xb_ld(&bar[XB_XGEN(b.x)]) == gen, bar);
            __builtin_amdgcn_fence(__ATOMIC_ACQUIRE, "agent");
            asm volatile("s_waitcnt vmcnt(0)" ::: "memory");
        }
    }
    __syncthreads();
}

namespace fg {
constexpr int BM = 256, BK = 64, HALF = 128, HTB = HALF * BK * 2, STAGE_BYTES = 8 * HTB;
__host__ __device__ __forceinline__ int lds_byte(int r, int c) { const int st = (r >> 4) * 2 + (c >> 5), rr = r & 15, cc = c & 31, ob = rr * 64 + cc * 2; return st * 1024 + (ob ^ (((ob >> 9) & 1) << 5)); }
__host__ __device__ __forceinline__ void stage_rc(int b, int& R, int& C) { const int st = b / 1024, sb = b % 1024, swz = sb ^ (((sb >> 9) & 1) << 5); R = (st >> 1) * 16 + swz / 64; C = (st & 1) * 32 + (swz % 64) / 2; }
__host__ __device__ __forceinline__ int perm32(int rho) { const int n = rho >> 4, i = rho & 15; return 8 * (i >> 2) + 4 * n + (i & 3); }
__device__ __forceinline__ unsigned cvt_pk_bf16(float lo, float hi) { unsigned r; asm volatile("v_cvt_pk_bf16_f32 %0, %1, %2" : "=v"(r) : "v"(lo), "v"(hi)); return r; }

struct GUnit {
    const char* A; const char* B;
    unsigned lda2, ldb2;
    int nt;
    const int* gat; int gn;
    int carry;
    int kind, pm, pn, x0, x1;
};
typedef f32x4 Acc[2][2][4][2];

template <class Sched, class Epi, bool GATHER>
__device__ __forceinline__ void gemm_stream(LAS unsigned char* lds, const Sched& S, const Epi& E) {
    const int tid = threadIdx.x, wid = __builtin_amdgcn_readfirstlane(tid >> 6), lane = tid & 63, wr = wid >> 2, wc = wid & 3, fr = lane & 15, fq = lane >> 4;
    int sR[2], sC2[2], sRb[2];
#pragma unroll
    for (int i = 0; i < 2; ++i) { int R, C; stage_rc(tid * 16 + i * 8192, R, C); sR[i] = R; sC2[i] = C * 2; sRb[i] = (R & ~31) + perm32(R & 31); }
    const unsigned ldsw = (unsigned)wid * 1024u;
    const int aoff = lds_byte(wr * 64 + fr, fq * 8), boff = lds_byte(wc * 32 + fr, fq * 8);
#define FG_SA(b, h) (((b) * 2 + (h)) * HTB)
#define FG_SB(b, h) ((4 + (b) * 2 + (h)) * HTB)
#define FG_STAGE(bufoff, gbase, v0, v1) do { \
        __builtin_amdgcn_global_load_lds((const unsigned*)((const char*)(gbase) + (v0)), (LAS unsigned*)(lds + (bufoff) + ldsw), 16, 0, 0); \
        __builtin_amdgcn_global_load_lds((const unsigned*)((const char*)(gbase) + (v1)), (LAS unsigned*)(lds + (bufoff) + ldsw + 8192), 16, 0, 0); } while (0)
#define FG_LDA(dst, b, h) do { _Pragma("unroll") for (int m = 0; m < 4; ++m) _Pragma("unroll") for (int k = 0; k < 2; ++k) dst[m][k] = *(const LAS bf16x8*)(lds + FG_SA(b, h) + aoff + m * 2048 + k * 1024); } while (0)
#define FG_LDB(dst, b, h) do { _Pragma("unroll") for (int n = 0; n < 2; ++n) _Pragma("unroll") for (int k = 0; k < 2; ++k) dst[n][k] = *(const LAS bf16x8*)(lds + FG_SB(b, h) + boff + n * 2048 + k * 1024); } while (0)
#define FG_MMA(ai, bj, At, Bt) do { __builtin_amdgcn_s_setprio(1); _Pragma("unroll") for (int m = 0; m < 4; ++m) _Pragma("unroll") for (int n = 0; n < 2; ++n) _Pragma("unroll") for (int k = 0; k < 2; ++k) \
        acc[ai][bj][m][n] = __builtin_amdgcn_mfma_f32_16x16x32_bf16(Bt[n][k], At[m][k], acc[ai][bj][m][n], 0, 0, 0); __builtin_amdgcn_s_setprio(0); } while (0)
#define FG_WAIT_V(n) asm volatile("s_waitcnt vmcnt(" #n ")" ::: "memory")
#define FG_WAIT_L(n) asm volatile("s_waitcnt lgkmcnt(" #n ")" ::: "memory")
#define FG_BAR __builtin_amdgcn_s_barrier()
#define FG_SCHED __builtin_amdgcn_sched_barrier(0)
#define FG_VOFF(u, vA, vB, hsA, hsB) do { \
        if constexpr (GATHER) { _Pragma("unroll") for (int h_ = 0; h_ < 2; ++h_) _Pragma("unroll") for (int i_ = 0; i_ < 2; ++i_) { const int r_ = sR[i_] + 128 * h_; const int tok_ = (r_ < (u).gn) ? (u).gat[r_] : 0; vA[h_][i_] = (unsigned)tok_ * (u).lda2 + (unsigned)sC2[i_]; } hsA = 0; } \
        else { _Pragma("unroll") for (int i_ = 0; i_ < 2; ++i_) { vA[0][i_] = (unsigned)sR[i_] * (u).lda2 + (unsigned)sC2[i_]; vA[1][i_] = vA[0][i_]; } hsA = (size_t)HALF * (u).lda2; } \
        _Pragma("unroll") for (int i_ = 0; i_ < 2; ++i_) vB[i_] = (unsigned)sRb[i_] * (u).ldb2 + (unsigned)sC2[i_]; hsB = (size_t)HALF * (u).ldb2; } while (0)
    GUnit cur, nxt; int ui = 0;
    if (!S.next(0, cur)) return;
    Acc acc;
#define FG_ZERO() do { _Pragma("unroll") for (int a = 0; a < 2; ++a) _Pragma("unroll") for (int b = 0; b < 2; ++b) _Pragma("unroll") for (int m = 0; m < 4; ++m) _Pragma("unroll") for (int n = 0; n < 2; ++n) acc[a][b][m][n] = (f32x4){0.f, 0.f, 0.f, 0.f}; } while (0)
    FG_ZERO();
    bf16x8 At[4][2], B0[2][2], B1[2][2];
    unsigned vAc[2][2], vBc[2], vAn[2][2], vBn[2]; size_t hsAc, hsBc, hsAn, hsBn;
    FG_VOFF(cur, vAc, vBc, hsAc, hsBc);
    const char* cA = cur.A; const char* cB = cur.B;
    FG_STAGE(FG_SB(0, 0), cB, vBc[0], vBc[1]); FG_STAGE(FG_SB(0, 1), cB + hsBc, vBc[0], vBc[1]); FG_STAGE(FG_SA(0, 0), cA, vAc[0][0], vAc[0][1]); FG_STAGE(FG_SA(0, 1), cA + hsAc, vAc[1][0], vAc[1][1]);
    if (wr == 1) FG_BAR;
    FG_WAIT_V(2); FG_BAR;
    FG_STAGE(FG_SB(1, 0), cB + 128, vBc[0], vBc[1]); FG_STAGE(FG_SA(1, 0), cA + 128, vAc[0][0], vAc[0][1]); FG_STAGE(FG_SB(1, 1), cB + hsBc + 128, vBc[0], vBc[1]);
    FG_WAIT_V(6); FG_BAR;
    for (;;) {
        const bool has_next = S.next(ui + 1, nxt);
        const char* nA = cA; const char* nB = cB;
        if (has_next) { FG_VOFF(nxt, vAn, vBn, hsAn, hsBn); nA = nxt.A; nB = nxt.B; }
        else { _Pragma("unroll") for (int i_ = 0; i_ < 2; ++i_) { vAn[0][i_] = vAc[0][i_]; vAn[1][i_] = vAc[1][i_]; vBn[i_] = vBc[i_]; } hsAn = hsAc; hsBn = hsBc; }
        const int nt = cur.nt;
        for (int t = 0; t < nt; t += 2) {
            const bool last = (t == nt - 2);
            const char* a1 = cA + (size_t)(t + 1) * 128;
            const char* a2 = last ? nA : cA + (size_t)(t + 2) * 128; const char* b2 = last ? nB : cB + (size_t)(t + 2) * 128;
            const char* a3 = a2 + 128; const char* b3 = b2 + 128;
            const unsigned xA00 = last ? vAn[0][0] : vAc[0][0], xA01 = last ? vAn[0][1] : vAc[0][1], xA10 = last ? vAn[1][0] : vAc[1][0], xA11 = last ? vAn[1][1] : vAc[1][1];
            const unsigned xB0 = last ? vBn[0] : vBc[0], xB1 = last ? vBn[1] : vBc[1];
            const size_t hA2 = last ? hsAn : hsAc, hB2 = last ? hsBn : hsBc;
            FG_LDB(B0, 0, 0); FG_LDB(B1, 0, 1); FG_SCHED; FG_LDA(At, 0, 0); FG_STAGE(FG_SA(1, 1), a1 + hsAc, vAc[1][0], vAc[1][1]);
            FG_WAIT_V(8); FG_WAIT_L(0); FG_BAR; FG_MMA(0, 0, At, B0); FG_MMA(0, 1, At, B1); FG_BAR; FG_SCHED;
            FG_LDA(At, 0, 1); FG_STAGE(FG_SB(0, 0), b2, xB0, xB1); FG_STAGE(FG_SB(0, 1), b2 + hB2, xB0, xB1); FG_STAGE(FG_SA(0, 0), a2, xA00, xA01);
            FG_WAIT_V(8); FG_WAIT_L(0); FG_BAR; FG_MMA(1, 0, At, B0); FG_MMA(1, 1, At, B1); FG_BAR; FG_SCHED;
            FG_LDB(B0, 1, 0); FG_LDB(B1, 1, 1); FG_SCHED; FG_LDA(At, 1, 0); FG_STAGE(FG_SA(0, 1), a2 + hA2, xA10, xA11);
            FG_WAIT_V(8); FG_WAIT_L(0); FG_BAR; FG_MMA(0, 0, At, B0); FG_MMA(0, 1, At, B1); FG_BAR; FG_SCHED;
            FG_LDA(At, 1, 1); FG_STAGE(FG_SB(1, 0), b3, xB0, xB1); FG_STAGE(FG_SB(1, 1), b3 + hB2, xB0, xB1); FG_STAGE(FG_SA(1, 0), a3, xA00, xA01);
            FG_WAIT_V(8); FG_WAIT_L(0); FG_BAR; FG_MMA(1, 0, At, B0); FG_MMA(1, 1, At, B1); FG_BAR; FG_SCHED;
        }
        if (wr == 0) FG_BAR;
        E(acc, cur, wr, wc, fr, fq, lds + EPI_OFF, wid, lane);
        if (!has_next) break;
        if (!nxt.carry) FG_ZERO();
        cur = nxt; cA = nA; cB = nB; ++ui;
#pragma unroll
        for (int i_ = 0; i_ < 2; ++i_) { vAc[0][i_] = vAn[0][i_]; vAc[1][i_] = vAn[1][i_]; vBc[i_] = vBn[i_]; }
        hsAc = hsAn; hsBc = hsBn;
        if (wr == 1) FG_BAR;
    }
    FG_WAIT_V(0);
    FG_BAR;
}
}

namespace fe {
using fg::Acc; using fg::GUnit; using fg::cvt_pk_bf16;
__device__ __forceinline__ v4u pack8(f32x4 a, f32x4 b) { v4u w; w.x = cvt_pk_bf16(a[0], a[1]); w.y = cvt_pk_bf16(a[2], a[3]); w.z = cvt_pk_bf16(b[0], b[1]); w.w = cvt_pk_bf16(b[2], b[3]); return w; }
__device__ __forceinline__ f32x4 unpack_lo(v4u w) { f32x4 r; r[0] = __builtin_bit_cast(float, w.x << 16); r[1] = __builtin_bit_cast(float, w.x & 0xffff0000u); r[2] = __builtin_bit_cast(float, w.y << 16); r[3] = __builtin_bit_cast(float, w.y & 0xffff0000u); return r; }
__device__ __forceinline__ f32x4 unpack_hi(v4u w) { f32x4 r; r[0] = __builtin_bit_cast(float, w.z << 16); r[1] = __builtin_bit_cast(float, w.z & 0xffff0000u); r[2] = __builtin_bit_cast(float, w.w << 16); r[3] = __builtin_bit_cast(float, w.w & 0xffff0000u); return r; }
__device__ __forceinline__ float fsigmoid(float v) { return __builtin_amdgcn_rcpf(1.f + __builtin_amdgcn_exp2f(-v * LOG2E)); }

__device__ __forceinline__ bool static_order(int i, int G, int c, int nM, int nN, int& pm, int& pn) {
    const long L = (long)i * G + c; const int nwg = nM * nN; if (L >= nwg) return false;
    int wgid = (int)L; { const int q = nwg / 8, r = nwg % 8, xcd = wgid % 8, off = wgid / 8; wgid = (xcd < r ? xcd * (q + 1) : r * (q + 1) + (xcd - r) * q) + off; }
    const int nig = 8 * nN, gid = wgid / nig, fm = gid * 8, gsz = (nM - fm) < 8 ? (nM - fm) : 8;
    pm = fm + ((wgid % nig) % gsz); pn = (wgid % nig) / gsz; return true;
}
struct SchedT {
    const char* A; const char* B; unsigned lda2, ldb2; int nt, nM, nN, G, c;
    __device__ __forceinline__ bool next(int i, GUnit& u) const {
        int pm, pn; if (!static_order(i, G, c, nM, nN, pm, pn)) return false;
        u.A = A + (size_t)pm * 256 * lda2; u.B = B + (size_t)pn * 256 * ldb2; u.lda2 = lda2; u.ldb2 = ldb2; u.nt = nt; u.gat = nullptr; u.gn = 0; u.carry = 0; u.kind = 0; u.pm = pm; u.pn = pn; u.x0 = pm * 256; u.x1 = 0; return true;
    }
};
struct EpiF32 { float* C; int ldc;
    __device__ __forceinline__ void operator()(Acc& acc, const GUnit& u, int wr, int wc, int fr, int fq, LAS unsigned char*, int, int) const {
        const int row0 = u.x0 + wr * 64 + fr, col0 = u.x1 + u.pn * 256 + wc * 32 + 8 * fq;
#pragma unroll
        for (int ai = 0; ai < 2; ++ai)
#pragma unroll
            for (int m = 0; m < 4; ++m) { float* rp = C + (size_t)(row0 + ai * 128 + m * 16) * ldc + col0;
#pragma unroll
                for (int bj = 0; bj < 2; ++bj) { *(f32x4*)(rp + bj * 128) = acc[ai][bj][m][0]; *(f32x4*)(rp + bj * 128 + 4) = acc[ai][bj][m][1]; } }
    }
};
struct EpiBf16 { bf16* C; int ldc; float scale;
    __device__ __forceinline__ void operator()(Acc& acc, const GUnit& u, int wr, int wc, int fr, int fq, LAS unsigned char*, int, int) const {
        const int row0 = u.x0 + wr * 64 + fr, col0 = u.x1 + u.pn * 256 + wc * 32 + 8 * fq;
#pragma unroll
        for (int ai = 0; ai < 2; ++ai)
#pragma unroll
            for (int m = 0; m < 4; ++m) { bf16* rp = C + (size_t)(row0 + ai * 128 + m * 16) * ldc + col0;
#pragma unroll
                for (int bj = 0; bj < 2; ++bj) *(v4u*)(rp + bj * 128) = pack8(acc[ai][bj][m][0] * scale, acc[ai][bj][m][1] * scale); }
    }
};
struct EpiGated { bf16* C;
    __device__ __forceinline__ void operator()(Acc& acc, const GUnit& u, int wr, int wc, int fr, int fq, LAS unsigned char*, int, int) const {
        const int row0 = u.x0 + wr * 64 + fr, col0 = u.pn * 128 + wc * 32 + 8 * fq;
#pragma unroll
        for (int ai = 0; ai < 2; ++ai)
#pragma unroll
            for (int m = 0; m < 4; ++m) { f32x4 o[2];
#pragma unroll
                for (int n = 0; n < 2; ++n)
#pragma unroll
                    for (int e = 0; e < 4; ++e) { const float a = acc[ai][0][m][n][e]; o[n][e] = a * fsigmoid(a) * acc[ai][1][m][n][e]; }
                *(v4u*)(C + (size_t)(row0 + ai * 128 + m * 16) * DFF + col0) = pack8(o[0], o[1]); }
    }
};

struct EpiIn { bf16 *aq, *ak, *av, *bq, *bk, *bv, *cdq, *cdkv, *kpe, *gates; float *ssq_q, *ssq_kv; const float *gqn, *gkn, *mqn, *mkvn, *cosb, *sinb, *cosc, *sinc;
    __device__ __forceinline__ void head_norm_rope(Acc& acc, int trow0, int fq, const float* gain, float scale, bf16* dst, int ldd) const {
        f32x4 g1[2], g2[2];
#pragma unroll
        for (int n = 0; n < 2; ++n) { g1[n] = *(const f32x4*)(gain + 8 * fq + 4 * n); g2[n] = *(const f32x4*)(gain + 32 + 8 * fq + 4 * n); }
#pragma unroll
        for (int ai = 0; ai < 2; ++ai)
#pragma unroll
            for (int m = 0; m < 4; ++m) { const int t = trow0 + ai * 128 + m * 16; const int pos = t & (SEQ - 1), tb = ((fq < 2) ? (pos >> 6) : (pos & 63)) * 16 + 8 * (fq & 1);
                float ss = 0.f;
#pragma unroll
                for (int bj = 0; bj < 2; ++bj)
#pragma unroll
                    for (int n = 0; n < 2; ++n) { const f32x4 x = acc[ai][bj][m][n]; ss += (x[0] * x[0] + x[1] * x[1]) + (x[2] * x[2] + x[3] * x[3]); }
                ss += __shfl_xor(ss, 16); ss += __shfl_xor(ss, 32);
                const float r = rsqrtf(ss * (1.f / 64.f) + 1e-6f); f32x4 o1[2], o2[2];
#pragma unroll
                for (int n = 0; n < 2; ++n) { const f32x4 c = *(const f32x4*)(cosb + tb + 4 * n), s = *(const f32x4*)(sinb + tb + 4 * n);
                    const f32x4 x1 = acc[ai][0][m][n] * r * g1[n], x2 = acc[ai][1][m][n] * r * g2[n]; o1[n] = (x1 * c - x2 * s) * scale; o2[n] = (x2 * c + x1 * s) * scale; }
                bf16* rp = dst + (size_t)t * ldd + 8 * fq; *(v4u*)rp = pack8(o1[0], o1[1]); *(v4u*)(rp + 32) = pack8(o2[0], o2[1]); }
    }
    __device__ __forceinline__ void operator()(Acc& acc, const GUnit& u, int wr, int wc, int fr, int fq, LAS unsigned char*, int, int) const {
        const int pn = u.pn, trow0 = u.pm * 256 + wr * 64 + fr, cw = wc * 32 + 8 * fq;
        if (pn <= 2 || pn >= 8) {
            bf16* dst; int ldd; float sc = 1.f; if (pn == 0) { dst = aq; ldd = 256; sc = C2_A; } else if (pn == 1) { dst = ak; ldd = 256; } else if (pn == 2) { dst = av; ldd = 256; } else { dst = gates + (pn - 8) * 256; ldd = 3072; }
#pragma unroll
            for (int ai = 0; ai < 2; ++ai)
#pragma unroll
                for (int m = 0; m < 4; ++m) { bf16* rp = dst + (size_t)(trow0 + ai * 128 + m * 16) * ldd + cw;
#pragma unroll
                    for (int bj = 0; bj < 2; ++bj) { f32x4 a = acc[ai][bj][m][0], b = acc[ai][bj][m][1];
                        if (pn >= 8) {
#pragma unroll
                            for (int e = 0; e < 4; ++e) { a[e] = fsigmoid(a[e]); b[e] = fsigmoid(b[e]); } }
                        else { a = a * sc; b = b * sc; }
                        *(v4u*)(rp + bj * 128) = pack8(a, b); } }
        } else if (pn == 3 || pn == 4) { head_norm_rope(acc, trow0, fq, gqn, C2_B, bq + ((pn - 3) * 4 + wc) * 64, 512);
        } else if (pn == 5) {
            if (wc < 2) head_norm_rope(acc, trow0, fq, gkn, 1.f, bk + wc * 64, 128);
            else {
#pragma unroll
                for (int ai = 0; ai < 2; ++ai)
#pragma unroll
                    for (int m = 0; m < 4; ++m) { bf16* rp = bv + (size_t)(trow0 + ai * 128 + m * 16) * 128 + (wc - 2) * 64 + 8 * fq;
#pragma unroll
                        for (int bj = 0; bj < 2; ++bj) *(v4u*)(rp + bj * 32) = pack8(acc[ai][bj][m][0], acc[ai][bj][m][1]); } }
        } else if (pn == 6) {
            f32x4 g[2][2];
#pragma unroll
            for (int bj = 0; bj < 2; ++bj)
#pragma unroll
                for (int n = 0; n < 2; ++n) g[bj][n] = *(const f32x4*)(mqn + bj * 128 + cw + 4 * n);
#pragma unroll
            for (int ai = 0; ai < 2; ++ai)
#pragma unroll
                for (int m = 0; m < 4; ++m) { const int t = trow0 + ai * 128 + m * 16; float ss = 0.f;
#pragma unroll
                    for (int bj = 0; bj < 2; ++bj)
#pragma unroll
                        for (int n = 0; n < 2; ++n) { const f32x4 x = acc[ai][bj][m][n]; ss += (x[0] * x[0] + x[1] * x[1]) + (x[2] * x[2] + x[3] * x[3]); }
                    ss += __shfl_xor(ss, 16); ss += __shfl_xor(ss, 32);
                    if (fq == 0) ssq_q[(size_t)t * 4 + wc] = ss;
#pragma unroll
                    for (int bj = 0; bj < 2; ++bj) *(v4u*)(cdq + (size_t)t * 256 + bj * 128 + cw) = pack8(acc[ai][bj][m][0] * g[bj][0], acc[ai][bj][m][1] * g[bj][1]); }
        } else {
            f32x4 g[2];
#pragma unroll
            for (int n = 0; n < 2; ++n) g[n] = *(const f32x4*)(mkvn + cw + 4 * n);
#pragma unroll
            for (int ai = 0; ai < 2; ++ai)
#pragma unroll
                for (int m = 0; m < 4; ++m) { const int t = trow0 + ai * 128 + m * 16; float ss = 0.f;
#pragma unroll
                    for (int n = 0; n < 2; ++n) { const f32x4 x = acc[ai][0][m][n]; ss += (x[0] * x[0] + x[1] * x[1]) + (x[2] * x[2] + x[3] * x[3]); }
                    ss += __shfl_xor(ss, 16); ss += __shfl_xor(ss, 32);
                    if (fq == 0) ssq_kv[(size_t)t * 4 + wc] = ss;
                    *(v4u*)(cdkv + (size_t)t * 128 + cw) = pack8(acc[ai][0][m][0] * g[0], acc[ai][0][m][1] * g[1]);
                    if (wc == 0) { const int pos = t & (SEQ - 1), tb = ((fq < 2) ? (pos >> 6) : (pos & 63)) * 8 + 4 * (fq & 1);
                        const f32x4 c = *(const f32x4*)(cosc + tb), s = *(const f32x4*)(sinc + tb), x1 = acc[ai][1][m][0], x2 = acc[ai][1][m][1];
                        const f32x4 o1 = x1 * c - x2 * s, o2 = x2 * c + x1 * s; v2u w1, w2; w1.x = cvt_pk_bf16(o1[0], o1[1]); w1.y = cvt_pk_bf16(o1[2], o1[3]); w2.x = cvt_pk_bf16(o2[0], o2[1]); w2.y = cvt_pk_bf16(o2[2], o2[3]);
                        *(v2u*)(kpe + (size_t)t * 32 + 4 * fq) = w1; *(v2u*)(kpe + (size_t)t * 32 + 16 + 4 * fq) = w2; } }
        }
    }
};

struct SchedMla { const char *cdq, *cdkv, *wuq, *wukv; int G, c;
    __device__ __forceinline__ bool next(int i, GUnit& u) const {
        const int L = i * G + c; if (L >= 256) return false; const int pm = L >> 2, s = L & 3;
        u.gat = nullptr; u.gn = 0; u.carry = 0; u.pm = pm; u.pn = s & 1; u.x0 = pm * 256; u.x1 = 0; u.kind = s >> 1;
        if (s < 2) { u.A = cdq + (size_t)pm * 256 * 512; u.lda2 = 512; u.B = wuq + (size_t)(s & 1) * 256 * 512; u.ldb2 = 512; u.nt = 4; }
        else { u.A = cdkv + (size_t)pm * 256 * 256; u.lda2 = 256; u.B = wukv + (size_t)(s & 1) * 256 * 256; u.ldb2 = 256; u.nt = 2; }
        return true;
    }
};
struct EpiMla { const float *ssq_q, *ssq_kv, *cosc, *sinc; bf16 *cq, *ck, *cv;
    __device__ __forceinline__ void operator()(Acc& acc, const GUnit& u, int wr, int wc, int fr, int fq, LAS unsigned char*, int, int) const {
        const int trow0 = u.pm * 256 + wr * 64 + fr;
#pragma unroll
        for (int ai = 0; ai < 2; ++ai)
#pragma unroll
            for (int m = 0; m < 4; ++m) { const int t = trow0 + ai * 128 + m * 16;
                if (u.kind == 0) { const f32x4 q4 = *(const f32x4*)(ssq_q + (size_t)t * 4); const float r = rsqrtf(((q4[0] + q4[1]) + (q4[2] + q4[3])) * (1.f / 256.f) + 1e-6f) * C2_C;
                    if (u.pn == 0) {
#pragma unroll
                        for (int bj = 0; bj < 2; ++bj) { const int h = 2 * bj + (wc >> 1), d = 32 * (wc & 1) + 8 * fq; *(v4u*)(cq + (size_t)t * 384 + h * 96 + d) = pack8(acc[ai][bj][m][0] * r, acc[ai][bj][m][1] * r); }
                    } else { const int pos = t & (SEQ - 1), tb = ((fq < 2) ? (pos >> 6) : (pos & 63)) * 8 + 4 * (fq & 1);
                        const f32x4 c = *(const f32x4*)(cosc + tb), s = *(const f32x4*)(sinc + tb), x1 = acc[ai][0][m][0] * r, x2 = acc[ai][0][m][1] * r;
                        const f32x4 o1 = x1 * c - x2 * s, o2 = x2 * c + x1 * s; v2u w1, w2; w1.x = cvt_pk_bf16(o1[0], o1[1]); w1.y = cvt_pk_bf16(o1[2], o1[3]); w2.x = cvt_pk_bf16(o2[0], o2[1]); w2.y = cvt_pk_bf16(o2[2], o2[3]);
                        bf16* rp = cq + (size_t)t * 384 + wc * 96 + 64 + 4 * fq; *(v2u*)rp = w1; *(v2u*)(rp + 16) = w2; }
                } else { const f32x4 q4 = *(const f32x4*)(ssq_kv + (size_t)t * 4); const float r = rsqrtf(((q4[0] + q4[1]) + (q4[2] + q4[3])) * (1.f / 128.f) + 1e-6f);
#pragma unroll
                    for (int bj = 0; bj < 2; ++bj) { const int h = 2 * u.pn + bj; bf16* rp = ((wc < 2) ? ck : cv) + (size_t)t * 256 + h * 64 + 32 * (wc & 1) + 8 * fq; *(v4u*)rp = pack8(acc[ai][bj][m][0] * r, acc[ai][bj][m][1] * r); } }
            }
    }
};

struct SchedMerge { const char *ya, *yb, *yc, *wa, *wb, *wc; int G, c;
    __device__ __forceinline__ bool next(int i, GUnit& u) const {
        int pm, pn; if (!static_order(i / 3, G, c, 64, 4, pm, pn)) return false; const int s = i % 3;
        u.gat = nullptr; u.gn = 0; u.carry = (s != 0); u.pm = pm; u.pn = pn; u.x0 = pm * 256; u.x1 = 0; u.kind = s;
        if (s == 0) { u.A = ya + (size_t)pm * 256 * 512; u.lda2 = 512; u.B = wa + (size_t)pn * 256 * 512; u.ldb2 = 512; u.nt = 4; }
        else if (s == 1) { u.A = yb + (size_t)pm * 256 * 1024; u.lda2 = 1024; u.B = wb + (size_t)pn * 256 * 1024; u.ldb2 = 1024; u.nt = 8; }
        else { u.A = yc + (size_t)pm * 256 * 512; u.lda2 = 512; u.B = wc + (size_t)pn * 256 * 512; u.ldb2 = 512; u.nt = 4; }
        return true;
    }
};
struct EpiMerge { const bf16* gates; bf16* merged;
    __device__ __forceinline__ void operator()(Acc& acc, const GUnit& u, int wr, int wc, int fr, int fq, LAS unsigned char*, int, int) const {
        const int trow0 = u.pm * 256 + wr * 64 + fr, col0 = u.pn * 256 + wc * 32 + 8 * fq, s = u.kind;
#pragma unroll
        for (int ai = 0; ai < 2; ++ai)
#pragma unroll
            for (int m = 0; m < 4; ++m) { const int t = trow0 + ai * 128 + m * 16; const bf16* gp = gates + (size_t)t * 3072 + col0;
#pragma unroll
                for (int bj = 0; bj < 2; ++bj) { const v4u ga = *(const v4u*)(gp + s * 1024 + bj * 128); f32x4 f0 = unpack_lo(ga), f1 = unpack_hi(ga);
                    if (s < 2) { const v4u gb = *(const v4u*)(gp + (s + 1) * 1024 + bj * 128); const f32x4 d0 = unpack_lo(gb), d1 = unpack_hi(gb);
#pragma unroll
                        for (int e = 0; e < 4; ++e) { f0[e] *= __builtin_amdgcn_rcpf(fmaxf(d0[e], 1e-30f)); f1[e] *= __builtin_amdgcn_rcpf(fmaxf(d1[e], 1e-30f)); } }
                    acc[ai][bj][m][0] *= f0; acc[ai][bj][m][1] *= f1;
                    if (s == 2) *(v4u*)(merged + (size_t)t * 1024 + col0 + bj * 128) = pack8(acc[ai][bj][m][0], acc[ai][bj][m][1]); } }
    }
};

struct SchedXS { const char *xq, *memk; int G, c;
    __device__ __forceinline__ bool next(int i, GUnit& u) const {
        const int L = i * G + c; if (L >= 256) return false; const int pm = L >> 2, h = L & 3, b = pm >> 4;
        u.A = xq + (size_t)pm * 256 * 2048 + h * 512; u.lda2 = 2048; u.B = memk + (size_t)b * 256 * 2048 + h * 512; u.ldb2 = 2048; u.nt = 4; u.gat = nullptr; u.gn = 0; u.carry = 0; u.kind = 0; u.pm = pm; u.pn = 0; u.x0 = pm * 256; u.x1 = h * 256; return true;
    }
};
struct SchedXO { const char *px, *memvt; int G, c;
    __device__ __forceinline__ bool next(int i, GUnit& u) const {
        const int L = i * G + c; if (L >= 256) return false; const int pm = L >> 2, h = L & 3, b = pm >> 4;
        u.A = px + (size_t)pm * 256 * 2048 + h * 512; u.lda2 = 2048; u.B = memvt + (size_t)h * 256 * 2048 + b * 512; u.ldb2 = 2048; u.nt = 4; u.gat = nullptr; u.gn = 0; u.carry = 0; u.kind = 0; u.pm = pm; u.pn = 0; u.x0 = pm * 256; u.x1 = h * 256; return true;
    }
};
struct EpiXS { bf16* px;
    __device__ __forceinline__ void operator()(Acc& acc, const GUnit& u, int wr, int wc, int fr, int fq, LAS unsigned char* lds, int, int) const {
        LAS float* red = (LAS float*)lds; LAS float* red2 = red + 1024;
        float mx[2][4];
#pragma unroll
        for (int ai = 0; ai < 2; ++ai)
#pragma unroll
            for (int m = 0; m < 4; ++m) { float v = -INFINITY;
#pragma unroll
                for (int bj = 0; bj < 2; ++bj)
#pragma unroll
                    for (int n = 0; n < 2; ++n) { const f32x4 x = acc[ai][bj][m][n]; v = fmaxf(v, fmaxf(fmaxf(x[0], x[1]), fmaxf(x[2], x[3]))); }
                v = fmaxf(v, __shfl_xor(v, 16)); v = fmaxf(v, __shfl_xor(v, 32)); mx[ai][m] = v;
                if (fq == 0) red[(ai * 128 + wr * 64 + m * 16 + fr) * 4 + wc] = v; }
        asm volatile("s_waitcnt lgkmcnt(0)" ::: "memory"); __builtin_amdgcn_s_barrier(); asm volatile("" ::: "memory");
        float sm[2][4];
#pragma unroll
        for (int ai = 0; ai < 2; ++ai)
#pragma unroll
            for (int m = 0; m < 4; ++m) { const f32x4 q = *(const LAS f32x4*)(red + (ai * 128 + wr * 64 + m * 16 + fr) * 4); const float mt = fmaxf(fmaxf(q[0], q[1]), fmaxf(q[2], q[3])); float s = 0.f;
#pragma unroll
                for (int bj = 0; bj < 2; ++bj)
#pragma unroll
                    for (int n = 0; n < 2; ++n)
#pragma unroll
                        for (int e = 0; e < 4; ++e) { const float p = __builtin_amdgcn_exp2f(acc[ai][bj][m][n][e] - mt); acc[ai][bj][m][n][e] = p; s += p; }
                s += __shfl_xor(s, 16); s += __shfl_xor(s, 32); sm[ai][m] = s;
                if (fq == 0) red2[(ai * 128 + wr * 64 + m * 16 + fr) * 4 + wc] = s; }
        asm volatile("s_waitcnt lgkmcnt(0)" ::: "memory"); __builtin_amdgcn_s_barrier(); asm volatile("" ::: "memory");
        const int row0 = u.x0 + wr * 64 + fr, col0 = u.x1 + wc * 32 + 8 * fq;
#pragma unroll
        for (int ai = 0; ai < 2; ++ai)
#pragma unroll
            for (int m = 0; m < 4; ++m) { const f32x4 q = *(const LAS f32x4*)(red2 + (ai * 128 + wr * 64 + m * 16 + fr) * 4); const float il = __builtin_amdgcn_rcpf((q[0] + q[1]) + (q[2] + q[3]));
                bf16* rp = px + (size_t)(row0 + ai * 128 + m * 16) * 1024 + col0;
#pragma unroll
                for (int bj = 0; bj < 2; ++bj) *(v4u*)(rp + bj * 128) = pack8(acc[ai][bj][m][0] * il, acc[ai][bj][m][1] * il); }
        (void)mx; (void)sm;
    }
};

struct SchedMoe { const char* A; const char* W; size_t wstride; unsigned lda2, ldb2; int nt, nN; const int* list; const int* segbase; const int* segcnt; int G, c; bool gather;
    __device__ __forceinline__ bool next(int i, GUnit& u) const {
        const int L = i * G + c; const int nrt = segbase[NE] >> 8; if (L >= nrt * nN) return false;
        const int rt = L / nN, pn = L % nN, row0 = rt * 256; int e = 0;
#pragma unroll
        for (int k = 1; k < NE; ++k) if (row0 >= segbase[k]) e = k;
        u.B = W + (size_t)e * wstride + (size_t)pn * 256 * ldb2; u.ldb2 = ldb2; u.lda2 = lda2; u.nt = nt; u.carry = 0; u.kind = 0; u.pm = rt; u.pn = pn; u.x0 = row0; u.x1 = 0;
        if (gather) { u.A = A; u.gat = list + row0; int gn = segbase[e] + segcnt[e] - row0; u.gn = gn > 256 ? 256 : gn; }
        else { u.A = A + (size_t)row0 * lda2; u.gat = nullptr; u.gn = 0; }
        return true;
    }
};
}

namespace fa {
constexpr int A_SLOT = 20480, A_NSL = 3, A_WS = A_NSL * A_SLOT  , A_OST = A_WS + 2048, A_END = A_OST + NWAVES * 4096;
static_assert(A_END <= RING_BYTES, "attention LDS map");
constexpr float THR = 8.f;
__device__ __forceinline__ int crow(int r, int hi) { return (r & 3) + 8 * (r >> 2) + 4 * hi; }
__device__ __forceinline__ void glds16(const void* gsrc, unsigned lds_dst) { unsigned keep;
    asm volatile("s_mov_b32 %0, m0\n\ts_mov_b32 m0, %2\n\ts_nop 0\n\tglobal_load_lds_dwordx4 %1, off\n\ts_mov_b32 m0, %0" : "=&s"(keep) : "v"(gsrc), "s"(lds_dst) : "memory"); }
typedef short v4i16_t __attribute__((ext_vector_type(4)));
__device__ __forceinline__ s16x4 vtr(const LAS char* p) { return __builtin_bit_cast(s16x4, __builtin_amdgcn_ds_read_tr16_b64_v4i16((LAS v4i16_t*)p)); }
__device__ __forceinline__ unsigned cvtpk_s(float lo, float hi) { typedef __bf16 bf16x2_t __attribute__((ext_vector_type(2))); f32x2 v = {lo, hi}; bf16x2_t b = __builtin_convertvector(v, bf16x2_t); return __builtin_bit_cast(unsigned, b); }
#define FA_WAIT_BAR(N) asm volatile("s_waitcnt vmcnt(" #N ") lgkmcnt(0)\n\ts_barrier" ::: "memory")

struct AttnArgs {
    const bf16* Qw; int pitchQ;
    const bf16* K1; int pitchK1;
    const bf16* K2; int pitchK2;
    const bf16* V; int pitchV;
    bf16* Ow; int pitchO;
    int NT;
    int t_lo, t_hi;
    int dr0;
    int cq0;
    const LAS float* rpbs;
};

template <int DK1, int DK2, int DV, bool NA>
__device__ __forceinline__ void attn_unit(LAS unsigned char* shm, const AttnArgs& a) {
    constexpr int DK = DK1 + DK2, NKC = DK / 8, ND0 = DK / 16, NG = DV / 32, KB = 64 * DK * 2;
    static_assert(KB + 64 * DV * 2 <= A_SLOT && DV == 64, "slot size / DV");
    const int tid = threadIdx.x, lane = tid & 63, r32 = lane & 31, hi = lane >> 5; const int wid = __builtin_amdgcn_readfirstlane(tid >> 6);
    const unsigned lds0 = (unsigned)(size_t)shm;
    LAS float* wsf = (LAS float*)(shm + A_WS) + wid * 64;
    bf16x8 qr[ND0];
#pragma unroll
    for (int d0 = 0; d0 < ND0; ++d0) qr[d0] = *(const bf16x8*)(a.Qw + (size_t)r32 * a.pitchQ + d0 * 16 + hi * 8);
#define FA_DMA(t_, s_) do { const unsigned sb_ = lds0 + (unsigned)(s_) * A_SLOT; \
        _Pragma("unroll") for (int cc_ = 0; cc_ < 2; ++cc_) { const int c_ = wid + 8 * cc_; if (c_ < NKC) { \
            const bf16* src_ = (c_ < DK1 / 8) ? (a.K1 + (size_t)(64 * (t_) + lane) * a.pitchK1 + c_ * 8) : (a.K2 + (size_t)(64 * (t_) + lane) * a.pitchK2 + (c_ - DK1 / 8) * 8); \
            glds16(src_, (unsigned)__builtin_amdgcn_readfirstlane(sb_ + c_ * 1024)); } } \
        { const int g_ = wid >> 2, ks_ = wid & 3; const bf16* src_ = a.V + (size_t)(64 * (t_) + 16 * ks_ + (lane >> 2)) * a.pitchV + g_ * 32 + (lane & 3) * 8; \
          glds16(src_, (unsigned)__builtin_amdgcn_readfirstlane(sb_ + KB + g_ * 4096 + ks_ * 1024)); } } while (0)
    FA_DMA(0, 0); if (a.NT > 1) FA_DMA(1, 1);
    float mhat = 0.f, l_reg = 0.f; f32x16 o[NG];
#pragma unroll
    for (int g = 0; g < NG; ++g) o[g] = f32x16{};
    f32x16 negm = f32x16{};
    bool started = false;
    int s_cur = 0;
    for (int t = 0; t < a.NT; ++t) {
        if (t + 1 < a.NT) { FA_WAIT_BAR(2); } else { FA_WAIT_BAR(0); }
        if (t + 2 < a.NT) FA_DMA(t + 2, (s_cur + 2) % 3);
        if (!NA || (t >= a.t_lo && t < a.t_hi)) {
            const LAS unsigned char* Ks = shm + s_cur * A_SLOT; const LAS unsigned char* kb = Ks + hi * 1024 + r32 * 16;
            f32x16 p0 = negm, p1 = negm;
#pragma unroll
            for (int d0 = 0; d0 < ND0; ++d0) { const bf16x8 b0 = *(const LAS bf16x8*)(kb + d0 * 2048), b1 = *(const LAS bf16x8*)(kb + d0 * 2048 + 512);
                p0 = __builtin_amdgcn_mfma_f32_32x32x16_bf16(b0, qr[d0], p0, 0, 0, 0); p1 = __builtin_amdgcn_mfma_f32_32x32x16_bf16(b1, qr[d0], p1, 0, 0, 0); }
            if constexpr (NA) { const int c = a.cq0 + r32; int cs = c - 8; cs = cs < 0 ? 0 : (cs > 48 ? 48 : cs); const LAS float* brow = a.rpbs + (a.dr0 + t) * 32;
#pragma unroll
                for (int r = 0; r < 16; ++r) { const int kc = crow(r, hi); const int dc0 = kc - c + 15, dc1 = dc0 + 32;
                    const float b0 = brow[dc0 & 31], b1 = brow[dc1 & 31];
                    p0[r] = ((unsigned)(kc - cs) < 16u) ? p0[r] + b0 : -INFINITY; p1[r] = ((unsigned)(kc + 32 - cs) < 16u) ? p1[r] + b1 : -INFINITY; } }
            float rm = fmaxf(p0[0], p1[0]);
#pragma unroll
            for (int r = 1; r < 16; ++r) rm = fmaxf(rm, fmaxf(p0[r], p1[r]));
            { auto rr = __builtin_amdgcn_permlane32_swap(__float_as_uint(rm), __float_as_uint(rm), false, false); rm = fmaxf(__uint_as_float(rr[0]), __uint_as_float(rr[1])); }
            bool resc = false;
            if (!started) { const float dl = rm; mhat = dl;
#pragma unroll
                for (int r = 0; r < 16; ++r) { p0[r] -= dl; p1[r] -= dl; }
#pragma unroll
                for (int r = 0; r < 16; ++r) negm[r] = -mhat;
                started = true;
            } else if (__any(rm > THR)) { const float dl = fmaxf(rm, 0.f); mhat += dl;
#pragma unroll
                for (int r = 0; r < 16; ++r) { p0[r] -= dl; p1[r] -= dl; }
#pragma unroll
                for (int r = 0; r < 16; ++r) negm[r] = -mhat;
                const float f = __builtin_amdgcn_exp2f(-dl); l_reg *= f; if (hi == 0) wsf[r32] = f; resc = true; }
            float sacc = 0.f;
#pragma unroll
            for (int r = 0; r < 16; ++r) { p0[r] = __builtin_amdgcn_exp2f(p0[r]); p1[r] = __builtin_amdgcn_exp2f(p1[r]); sacc += p0[r] + p1[r]; }
            l_reg += sacc;
            if (resc) { asm volatile("s_waitcnt lgkmcnt(0)" ::: "memory");
#pragma unroll
                for (int g = 0; g < NG; ++g)
#pragma unroll
                    for (int r = 0; r < 16; ++r) o[g][r] *= wsf[crow(r, hi)]; }
            bf16x8 pa[4];
#pragma unroll
            for (int s = 0; s < 4; ++s) { const int b = 8 * (s & 1); v4u w;
                if (s < 2) { w.x = cvtpk_s(p0[b], p0[b + 1]); w.y = cvtpk_s(p0[b + 2], p0[b + 3]); w.z = cvtpk_s(p0[b + 4], p0[b + 5]); w.w = cvtpk_s(p0[b + 6], p0[b + 7]); }
                else { w.x = cvtpk_s(p1[b], p1[b + 1]); w.y = cvtpk_s(p1[b + 2], p1[b + 3]); w.z = cvtpk_s(p1[b + 4], p1[b + 5]); w.w = cvtpk_s(p1[b + 6], p1[b + 7]); }
                pa[s] = __builtin_bit_cast(bf16x8, w); }
            const LAS char* vp = (const LAS char*)(Ks + KB) + ((lane >> 4) & 1) * 32 + (lane & 3) * 8 + (4 * hi + ((lane & 15) >> 2)) * 64;
#pragma unroll
            for (int g = 0; g < NG; ++g)
#pragma unroll
                for (int s = 0; s < 4; ++s) { const s16x4 lo = vtr(vp + g * 4096 + s * 1024), hh = vtr(vp + g * 4096 + s * 1024 + 512);
                    const bf16x8 vf = (bf16x8){lo[0], lo[1], lo[2], lo[3], hh[0], hh[1], hh[2], hh[3]};
                    o[g] = __builtin_amdgcn_mfma_f32_32x32x16_bf16(pa[s], vf, o[g], 0, 0, 0); }
        }
        s_cur = (s_cur + 1) % 3;
    }
    { auto rr = __builtin_amdgcn_permlane32_swap(__float_as_uint(l_reg), __float_as_uint(l_reg), false, false); l_reg = __uint_as_float(rr[0]) + __uint_as_float(rr[1]); }
    if (hi == 0) wsf[32 + r32] = l_reg; asm volatile("s_waitcnt lgkmcnt(0)" ::: "memory");
    LAS bf16* stg = (LAS bf16*)(shm + A_OST) + wid * 2048;
#pragma unroll
    for (int r = 0; r < 16; ++r) { const int orow = crow(r, hi); const float rl = __builtin_amdgcn_rcpf(wsf[32 + orow]);
#pragma unroll
        for (int g = 0; g < NG; ++g) stg[orow * 64 + g * 32 + r32] = (bf16)f2bf(o[g][r] * rl); }
    asm volatile("s_waitcnt lgkmcnt(0)" ::: "memory");
#pragma unroll
    for (int i = 0; i < 4; ++i) { const int row = i * 8 + (lane >> 3), ch = lane & 7; const v4u v = *(const LAS v4u*)(stg + row * 64 + ch * 8); *(v4u*)(a.Ow + (size_t)row * a.pitchO + ch * 8) = v; }
    asm volatile("s_waitcnt vmcnt(0) lgkmcnt(0)\n\ts_barrier" ::: "memory");
}
}

constexpr size_t O_WIN = 0, O_WUQ = 5242880, O_WUKV = 5373952, O_WPA = 5439488, O_WPB = 5701632, O_WPC = 6225920, O_WOUT = 6488064, O_WQ = 7536640, O_WKV = 8585216, O_WO = 10682368, LSTRIDE = 11730944;
constexpr size_t O_GU = 0, O_DOWN = 5767168, FSTRIDE = 8650752;
constexpr size_t W_FFN = 4 * LSTRIDE, W_MOE = W_FFN + 2 * FSTRIDE, W_TOTAL = W_MOE + 16 * FSTRIDE;
static_assert(WS_WEIGHTS + W_TOTAL * 2 <= WS_END, "weights fit");

struct FP { const float* in[26]; float* out; unsigned char* ws; int l; int pad; };
struct Ctx {
    LAS unsigned char* lds; int tid, lane, wave, vcu, G, bx; unsigned char* ws; const FP* p;
    __device__ __forceinline__ bf16* W(size_t off) const { return (bf16*)(ws + WS_WEIGHTS) + off; }
    template <class Tp> __device__ __forceinline__ Tp* at(size_t off) const { return (Tp*)(ws + off); }
};
__device__ __forceinline__ float wave_sum_f(float v) {
#pragma unroll
    for (int o = 1; o < 64; o <<= 1) v += __shfl_xor(v, o);
    return v;
}

__device__ __forceinline__ int pe_perm(int w) { return 16 * ((w >> 2) & 1) + 4 * (w >> 3) + (w & 3); }
__device__ __forceinline__ void conv_item(const float* W, int K, int Nsrc, bf16* WT, int grp, int kb, int lb, bool perm, LAS float* scr, int lane) {
    const int k0 = 64 * kb, c = lane & 7;
    if (lb < 0) {
#pragma unroll
        for (int j = 0; j < 4; ++j) { const int n = (lane >> 3) + 8 * j; *(GAS v4u*)(WT + (size_t)(grp * 32 + n) * K + k0 + 8 * c) = (v4u){0u, 0u, 0u, 0u}; }
        return; }
#pragma unroll 16
    for (int i = 0; i < 32; ++i) { const int kk = 2 * i + (lane >> 5); scr[kk * 33 + (lane & 31)] = W[(size_t)(k0 + kk) * Nsrc + lb + (lane & 31)]; }
    LDS_WAIT(); asm volatile("" ::: "memory");
#pragma unroll
    for (int j = 0; j < 4; ++j) { const int n = (lane >> 3) + 8 * j; const int ns = perm ? pe_perm(n) : n; const LAS float* s = scr + (8 * c) * 33 + ns;
        v4u o; o.x = f2bf(s[0 * 33]) | (f2bf(s[1 * 33]) << 16); o.y = f2bf(s[2 * 33]) | (f2bf(s[3 * 33]) << 16); o.z = f2bf(s[4 * 33]) | (f2bf(s[5 * 33]) << 16); o.w = f2bf(s[6 * 33]) | (f2bf(s[7 * 33]) << 16);
        *(GAS v4u*)(WT + (size_t)(grp * 32 + n) * K + k0 + 8 * c) = o; }
    LDS_WAIT(); asm volatile("" ::: "memory");
}
__device__ __forceinline__ int gmap_in(int G, bool& perm) { const int pn = G >> 3, g8 = G & 7, bj = g8 >> 2, wc = g8 & 3; perm = false;
    if (pn <= 2) return pn * 256 + g8 * 32;
    if (pn <= 4) return 768 + (pn - 3) * 256 + wc * 64 + bj * 32;
    if (pn == 5) return (wc < 2) ? (1280 + wc * 64 + bj * 32) : (1408 + (wc - 2) * 64 + bj * 32);
    if (pn == 6) return 1536 + g8 * 32;
    if (pn == 7) { if (g8 < 4) return 1792 + g8 * 32; if (g8 == 4) { perm = true; return 1920; } return -1; }
    return 1952 + (pn - 8) * 256 + g8 * 32; }
__device__ __forceinline__ int gmap_uq(int G, bool& perm) { perm = false; if (G < 8) return 96 * (G >> 1) + 32 * (G & 1); if (G < 12) { perm = true; return 96 * (G - 8) + 64; } return -1; }
__device__ __forceinline__ int gmap_gu(int G) { const int pn = G >> 3, g8 = G & 7; return ((g8 >> 2) ? DFF : 0) + 128 * pn + 32 * (g8 & 3); }

constexpr int NJOB = 14;
__device__ __forceinline__ void ph_convert(const Ctx& c) {
    const FP& p = *c.p;
    LAS float* scr = (LAS float*)(c.lds + c.wave * 16384);
    const int gw = c.vcu * NWAVES + c.wave, NGW = c.G * NWAVES;
    constexpr int J_REPS[NJOB] = {4, 4, 4, 4, 4, 4, 4, 4, 4, 4, 2, 2, 16, 16};
    constexpr int J_K[NJOB] = {1024, 256, 128, 256, 512, 256, 1024, 1024, 1024, 1024, 1024, 2816, 1024, 2816};
    constexpr int J_NS[NJOB] = {5024, 384, 512, 1024, 1024, 1024, 1024, 1024, 2048, 1024, 5632, 1024, 5632, 1024};
    constexpr int J_NG[NJOB] = {160, 16, 16, 32, 32, 32, 32, 32, 64, 32, 176, 32, 176, 32};
    constexpr int J_IN[NJOB] = {4, 10, 11, 12, 13, 14, 15, 16, 17, 18, 21, 22, 24, 25};
    int total = 0;
#pragma unroll
    for (int j = 0; j < NJOB; ++j) total += J_REPS[j] * J_NG[j] * (J_K[j] / 64);
    for (int it = gw; it < total; it += NGW) {
        int r = it, job = 0, K = 0, NS = 0, NGp = 0, rep = 0; bool found = false;
#pragma unroll
        for (int j = 0; j < NJOB; ++j) { const int per = J_NG[j] * (J_K[j] / 64), cnt = J_REPS[j] * per;
            if (!found) { if (r < cnt) { found = true; job = j; K = J_K[j]; NS = J_NS[j]; NGp = J_NG[j]; rep = r / per; r = r % per; } else r -= cnt; } }
        const int kb = r / NGp, grp = r % NGp;
        const float* src = p.in[J_IN[0]]; bf16* dst = c.W(0); int lb = grp * 32; bool perm = false;
        switch (job) {
            case 0: src = p.in[4] + (size_t)rep * D * INC; dst = c.W(rep * LSTRIDE + O_WIN); lb = gmap_in(grp, perm); break;
            case 1: src = p.in[10] + (size_t)rep * 256 * 384; dst = c.W(rep * LSTRIDE + O_WUQ); lb = gmap_uq(grp, perm); break;
            case 2: src = p.in[11] + (size_t)rep * 128 * 512; dst = c.W(rep * LSTRIDE + O_WUKV); break;
            case 3: src = p.in[12] + (size_t)rep * 256 * D; dst = c.W(rep * LSTRIDE + O_WPA); break;
            case 4: src = p.in[13] + (size_t)rep * 512 * D; dst = c.W(rep * LSTRIDE + O_WPB); break;
            case 5: src = p.in[14] + (size_t)rep * 256 * D; dst = c.W(rep * LSTRIDE + O_WPC); break;
            case 6: src = p.in[15] + (size_t)rep * D * D; dst = c.W(rep * LSTRIDE + O_WOUT); break;
            case 7: src = p.in[16] + (size_t)rep * D * D; dst = c.W(rep * LSTRIDE + O_WQ); break;
            case 8: src = p.in[17] + (size_t)rep * D * 2 * D; dst = c.W(rep * LSTRIDE + O_WKV); break;
            case 9: src = p.in[18] + (size_t)rep * D * D; dst = c.W(rep * LSTRIDE + O_WO); break;
            case 10: src = p.in[21] + (size_t)rep * D * 2 * DFF; dst = c.W(W_FFN + rep * FSTRIDE + O_GU); lb = gmap_gu(grp); break;
            case 11: src = p.in[22] + (size_t)rep * DFF * D; dst = c.W(W_FFN + rep * FSTRIDE + O_DOWN); break;
            case 12: src = p.in[24] + (size_t)rep * D * 2 * DFF; dst = c.W(W_MOE + rep * FSTRIDE + O_GU); lb = gmap_gu(grp); break;
            default: src = p.in[25] + (size_t)rep * DFF * D; dst = c.W(W_MOE + rep * FSTRIDE + O_DOWN); break;
        }
        conv_item(src, K, NS, dst, grp, kb, lb, perm, scr, c.lane);
    }
    { const int i = c.bx * 512 + c.tid; float* cosb = c.at<float>(WS_TAB); float* sinb = cosb + 1024; float* cosc = cosb + 2048; float* sinc = cosb + 2560;
      if (i < 64 * 16) { const int v = i / 16, j = i % 16; const float f = powf(10000.0f, -(float)j / 16.0f); const float a = (float)v * f; cosb[i] = cosf(a); sinb[i] = sinf(a); }
      if (i < 64 * 8) { const int v = i / 8, j = i % 8; const float f = powf(10000.0f, -(float)j / 8.0f); const float a = (float)v * f; cosc[i] = cosf(a); sinc[i] = sinf(a); } }
    { bf16* memb = c.at<bf16>(WS_MEMB); const float* mem = p.in[1];
      for (int i = (c.bx * 512 + c.tid) * 4; i < 1024 * 1024; i += c.G * 512 * 4) { const f32x4 v = *(const f32x4*)(mem + i); v2u w; w.x = f2bf(v[0]) | (f2bf(v[1]) << 16); w.y = f2bf(v[2]) | (f2bf(v[3]) << 16); *(v2u*)(memb + i) = w; } }
}

__device__ __forceinline__ void ph_ln(const Ctx& c, int mode, const float* g, const float* b, bool route, const float* wr, bool last) {
    const FP& p = *c.p; float* hf = c.at<float>(WS_HF); bf16* hb = c.at<bf16>(WS_HB); const float* pre = c.at<float>(WS_F); const float* y = c.at<float>(WS_Y);
    const int* tslot = c.at<int>(WS_ROUTE + 256 * 1024); const float* rw = c.at<float>(WS_ROUTE + 128 * 1024); int* re = c.at<int>(WS_ROUTE); float* rwo = c.at<float>(WS_ROUTE + 128 * 1024);
    const int gw = c.vcu * NWAVES + c.wave, NGW = c.G * NWAVES, lane = c.lane;
    f32x4 gg[4], bb[4];
#pragma unroll
    for (int j = 0; j < 4; ++j) { gg[j] = *(const f32x4*)(g + 4 * lane + 256 * j); bb[j] = *(const f32x4*)(b + 4 * lane + 256 * j); }
    for (int row = gw; row < T; row += NGW) {
        f32x4 v[4]; float s = 0.f; const size_t ro = (size_t)row * D + 4 * lane;
        if (mode == 0) {
#pragma unroll
            for (int j = 0; j < 4; ++j) v[j] = *(const f32x4*)(p.in[0] + ro + 256 * j);
        } else if (mode == 1) {
#pragma unroll
            for (int j = 0; j < 4; ++j) v[j] = *(const f32x4*)(hf + ro + 256 * j) * ALPHA + *(const f32x4*)(pre + ro + 256 * j);
        } else { const int s0 = tslot[row * 2], s1 = tslot[row * 2 + 1]; const float w0 = rw[row * 2], w1 = rw[row * 2 + 1];
#pragma unroll
            for (int j = 0; j < 4; ++j) v[j] = *(const f32x4*)(hf + ro + 256 * j) * ALPHA + (*(const f32x4*)(y + (size_t)s0 * D + 4 * lane + 256 * j) * w0 + *(const f32x4*)(y + (size_t)s1 * D + 4 * lane + 256 * j) * w1);
        }
#pragma unroll
        for (int j = 0; j < 4; ++j) s += (v[j][0] + v[j][1]) + (v[j][2] + v[j][3]);
        const float mean = wave_sum_f(s) * (1.f / D); float q = 0.f;
#pragma unroll
        for (int j = 0; j < 4; ++j) { v[j] = v[j] - mean; q += (v[j][0] * v[j][0] + v[j][1] * v[j][1]) + (v[j][2] * v[j][2] + v[j][3] * v[j][3]); }
        const float rstd = rsqrtf(wave_sum_f(q) * (1.f / D) + 1e-5f);
#pragma unroll
        for (int j = 0; j < 4; ++j) { v[j] = v[j] * rstd * gg[j] + bb[j]; *(f32x4*)(hf + ro + 256 * j) = v[j]; if (last) *(f32x4*)(p.out + ro + 256 * j) = v[j];
            v2u w; w.x = fg::cvt_pk_bf16(v[j][0], v[j][1]); w.y = fg::cvt_pk_bf16(v[j][2], v[j][3]); *(v2u*)(hb + ro + 256 * j) = w; }
        if (route) { float acc[NE];
#pragma unroll
            for (int e = 0; e < NE; ++e) acc[e] = 0.f;
#pragma unroll
            for (int j = 0; j < 4; ++j)
#pragma unroll
                for (int i = 0; i < 4; ++i) { const float* wp = wr + (size_t)(4 * lane + 256 * j + i) * NE; const f32x4 w0 = *(const f32x4*)wp, w1 = *(const f32x4*)(wp + 4); const float x = v[j][i];
                    acc[0] += x * w0[0]; acc[1] += x * w0[1]; acc[2] += x * w0[2]; acc[3] += x * w0[3]; acc[4] += x * w1[0]; acc[5] += x * w1[1]; acc[6] += x * w1[2]; acc[7] += x * w1[3]; }
#pragma unroll
            for (int e = 0; e < NE; ++e) acc[e] = wave_sum_f(acc[e]);
            if (lane == 0) { int e0 = 0; float l0 = acc[0];
#pragma unroll
                for (int e = 1; e < NE; ++e) if (acc[e] > l0) { l0 = acc[e]; e0 = e; }
                int e1 = -1; float l1 = -INFINITY;
#pragma unroll
                for (int e = 0; e < NE; ++e) if (e != e0 && acc[e] > l1) { l1 = acc[e]; e1 = e; }
                const float p1 = expf(l1 - l0), w0 = 1.f / (1.f + p1), w1 = p1 / (1.f + p1);
                re[row * 2] = e0; re[row * 2 + 1] = e1; rwo[row * 2] = w0; rwo[row * 2 + 1] = w1; } }
    }
}
__device__ __forceinline__ void ph_moe_count(const Ctx& c) {
    const int* re = c.at<int>(WS_ROUTE); int* cnt = c.at<int>(WS_ROUTE + 640 * 1024); const int gw = c.vcu * NWAVES + c.wave, NGW = c.G * NWAVES, lane = c.lane;
    for (int blk = gw; blk < T / 64; blk += NGW) { const int t = blk * 64 + lane; const int e0 = re[t * 2], e1 = re[t * 2 + 1];
#pragma unroll
        for (int e = 0; e < NE; ++e) { const unsigned long long mk = __ballot(e0 == e || e1 == e); if (lane == 0) cnt[blk * NE + e] = __popcll(mk); } }
}
__device__ __forceinline__ void ph_moe_assign(const Ctx& c) {
    const int* re = c.at<int>(WS_ROUTE); const int* cnt = c.at<int>(WS_ROUTE + 640 * 1024); int* tslot = c.at<int>(WS_ROUTE + 256 * 1024); int* list = c.at<int>(WS_ROUTE + 384 * 1024);
    int* segbase = c.at<int>(WS_ROUTE + 704 * 1024); int* segcnt = c.at<int>(WS_ROUTE + 705 * 1024);
    const int gw = c.vcu * NWAVES + c.wave, NGW = c.G * NWAVES, lane = c.lane;
    for (int blk = gw; blk < T / 64; blk += NGW) { const int t = blk * 64 + lane; const int e0 = re[t * 2], e1 = re[t * 2 + 1]; int base = 0;
#pragma unroll
        for (int e = 0; e < NE; ++e) { int s = 0, sb = 0;
#pragma unroll
            for (int k = 0; k < 4; ++k) { const int b2 = lane + 64 * k; const int cc = cnt[b2 * NE + e]; s += cc; if (b2 < blk) sb += cc; }
#pragma unroll
            for (int o = 1; o < 64; o <<= 1) { s += __shfl_xor(s, o); sb += __shfl_xor(sb, o); }
            if (blk == 0 && lane == 0) { segbase[e] = base; segcnt[e] = s; }
            const unsigned long long mk = __ballot(e0 == e || e1 == e); const int rank = __popcll(mk & ((1ull << lane) - 1ull));
            if (e0 == e || e1 == e) { const int slot = base + sb + rank; list[slot] = t; tslot[t * 2 + (e1 == e ? 1 : 0)] = slot; }
            base += (s + 255) & ~255; }
        if (blk == 0 && lane == 0) segbase[NE] = base; }
}

__device__ __forceinline__ void ph_memkv(const Ctx& c) {
    struct Sch { const char* memb; const char* w; bf16* memk; bf16* memvt; int G, c;
        __device__ __forceinline__ bool next(int i, fg::GUnit& u) const { const int L = i * G + c; if (L >= 128) return false; const int l = L >> 5, v = (L >> 4) & 1, pm = (L >> 2) & 3, pn = L & 3;
            const char* wl = w + (size_t)l * LSTRIDE * 2 + O_WKV * 2; u.lda2 = 2048; u.ldb2 = 2048; u.nt = 16; u.gat = nullptr; u.gn = 0; u.carry = 0; u.kind = l * 2 + v; u.pm = pm; u.pn = pn; u.x0 = pm * 256; u.x1 = 0;
            if (!v) { u.A = memb + (size_t)pm * 256 * 2048; u.B = wl + (size_t)pn * 256 * 2048; } else { u.A = wl + (size_t)(1024 + pm * 256) * 2048; u.B = memb + (size_t)pn * 256 * 2048; } return true; } };
    struct Ep { bf16* memk; bf16* memvt;
        __device__ __forceinline__ void operator()(fg::Acc& acc, const fg::GUnit& u, int wr, int wc, int fr, int fq, LAS unsigned char*, int, int) const {
            bf16* C = memk + (size_t)(u.kind & 1) * ((WS_MEMVT - WS_MEMK) / 2) + (size_t)(u.kind >> 1) * 1024 * 1024; const int row0 = u.x0 + wr * 64 + fr, col0 = u.pn * 256 + wc * 32 + 8 * fq;
#pragma unroll
            for (int ai = 0; ai < 2; ++ai)
#pragma unroll
                for (int m = 0; m < 4; ++m) { bf16* rp = C + (size_t)(row0 + ai * 128 + m * 16) * 1024 + col0;
#pragma unroll
                    for (int bj = 0; bj < 2; ++bj) *(v4u*)(rp + bj * 128) = fe::pack8(acc[ai][bj][m][0], acc[ai][bj][m][1]); } } };
    Sch S{(const char*)c.at<bf16>(WS_MEMB), (const char*)c.W(0), c.at<bf16>(WS_MEMK), c.at<bf16>(WS_MEMVT), c.G, c.bx}; Ep E{c.at<bf16>(WS_MEMK), c.at<bf16>(WS_MEMVT)};
    fg::gemm_stream<Sch, Ep, false>(c.lds, S, E);
}
__device__ __forceinline__ void ph_inproj(const Ctx& c, int l) {
    const FP& p = *c.p; float* tab = c.at<float>(WS_TAB);
    fe::SchedT S{(const char*)c.at<bf16>(WS_HB), (const char*)c.W(l * LSTRIDE + O_WIN), 2048, 2048, 16, 64, 20, c.G, c.bx};
    fe::EpiIn E{c.at<bf16>(WS_AQ), c.at<bf16>(WS_AK), c.at<bf16>(WS_AV), c.at<bf16>(WS_BQ), c.at<bf16>(WS_BK), c.at<bf16>(WS_BV), c.at<bf16>(WS_CDQ), c.at<bf16>(WS_CDKV), c.at<bf16>(WS_KPE), c.at<bf16>(WS_GATES),
        c.at<float>(WS_SSQQ), c.at<float>(WS_SSQKV), p.in[6] + l * 64, p.in[7] + l * 64, p.in[8] + l * 256, p.in[9] + l * 128, tab, tab + 1024, tab + 2048, tab + 2560};
    fg::gemm_stream<fe::SchedT, fe::EpiIn, false>(c.lds, S, E);
}
__device__ __forceinline__ void ph_mla(const Ctx& c, int l) {
    float* tab = c.at<float>(WS_TAB);
    fe::SchedMla S{(const char*)c.at<bf16>(WS_CDQ), (const char*)c.at<bf16>(WS_CDKV), (const char*)c.W(l * LSTRIDE + O_WUQ), (const char*)c.W(l * LSTRIDE + O_WUKV), c.G, c.bx};
    fe::EpiMla E{c.at<float>(WS_SSQQ), c.at<float>(WS_SSQKV), tab + 2048, tab + 2560, c.at<bf16>(WS_CQ), c.at<bf16>(WS_CK), c.at<bf16>(WS_CV)};
    fg::gemm_stream<fe::SchedMla, fe::EpiMla, false>(c.lds, S, E);
}
__device__ __forceinline__ void ph_merge(const Ctx& c, int l) {
    fe::SchedMerge S{(const char*)c.at<bf16>(WS_YA), (const char*)c.at<bf16>(WS_YB), (const char*)c.at<bf16>(WS_YC), (const char*)c.W(l * LSTRIDE + O_WPA), (const char*)c.W(l * LSTRIDE + O_WPB), (const char*)c.W(l * LSTRIDE + O_WPC), c.G, c.bx};
    fe::EpiMerge E{c.at<bf16>(WS_GATES), c.at<bf16>(WS_MERGED)};
    fg::gemm_stream<fe::SchedMerge, fe::EpiMerge, false>(c.lds, S, E);
}
__device__ __forceinline__ void ph_proj_pre(const Ctx& c, size_t a_off, size_t w_off) {
    fe::SchedT S{(const char*)c.at<bf16>(a_off), (const char*)c.W(w_off), 2048, 2048, 16, 64, 4, c.G, c.bx};
    fe::EpiF32 E{c.at<float>(WS_F), 1024};
    fg::gemm_stream<fe::SchedT, fe::EpiF32, false>(c.lds, S, E);
}
__device__ __forceinline__ void ph_xq(const Ctx& c, int l) {
    fe::SchedT S{(const char*)c.at<bf16>(WS_HB), (const char*)c.W(l * LSTRIDE + O_WQ), 2048, 2048, 16, 64, 4, c.G, c.bx};
    fe::EpiBf16 E{c.at<bf16>(WS_XQ), 1024, C2_X};
    fg::gemm_stream<fe::SchedT, fe::EpiBf16, false>(c.lds, S, E);
}
__device__ __forceinline__ void ph_xs(const Ctx& c, int l) {
    fe::SchedXS S{(const char*)c.at<bf16>(WS_XQ), (const char*)(c.at<bf16>(WS_MEMK) + (size_t)l * 1024 * 1024), c.G, c.bx};
    fe::EpiXS E{c.at<bf16>(WS_MERGED)};
    fg::gemm_stream<fe::SchedXS, fe::EpiXS, false>(c.lds, S, E);
}
__device__ __forceinline__ void ph_xo(const Ctx& c, int l) {
    fe::SchedXO S{(const char*)c.at<bf16>(WS_MERGED), (const char*)(c.at<bf16>(WS_MEMVT) + (size_t)l * 1024 * 1024), c.G, c.bx};
    fe::EpiBf16 E{c.at<bf16>(WS_XO), 1024, 1.f};
    fg::gemm_stream<fe::SchedXO, fe::EpiBf16, false>(c.lds, S, E);
}
__device__ __forceinline__ void ph_ffn1(const Ctx& c, int i) {
    fe::SchedT S{(const char*)c.at<bf16>(WS_HB), (const char*)c.W(W_FFN + i * FSTRIDE + O_GU), 2048, 2048, 16, 64, 22, c.G, c.bx};
    fe::EpiGated E{c.at<bf16>(WS_ACT)};
    fg::gemm_stream<fe::SchedT, fe::EpiGated, false>(c.lds, S, E);
}
__device__ __forceinline__ void ph_ffn2(const Ctx& c, int i) {
    fe::SchedT S{(const char*)c.at<bf16>(WS_ACT), (const char*)c.W(W_FFN + i * FSTRIDE + O_DOWN), 5632, 5632, 44, 64, 4, c.G, c.bx};
    fe::EpiF32 E{c.at<float>(WS_F), 1024};
    fg::gemm_stream<fe::SchedT, fe::EpiF32, false>(c.lds, S, E);
}
__device__ __forceinline__ void ph_moe1(const Ctx& c, int i) {
    fe::SchedMoe S{(const char*)c.at<bf16>(WS_HB), (const char*)c.W(W_MOE + (size_t)i * 8 * FSTRIDE + O_GU), FSTRIDE * 2, 2048, 2048, 16, 22, c.at<int>(WS_ROUTE + 384 * 1024), c.at<int>(WS_ROUTE + 704 * 1024), c.at<int>(WS_ROUTE + 705 * 1024), c.G, c.bx, true};
    fe::EpiGated E{c.at<bf16>(WS_ACT)};
    fg::gemm_stream<fe::SchedMoe, fe::EpiGated, true>(c.lds, S, E);
}
__device__ __forceinline__ void ph_moe2(const Ctx& c, int i) {
    fe::SchedMoe S{(const char*)c.at<bf16>(WS_ACT), (const char*)c.W(W_MOE + (size_t)i * 8 * FSTRIDE + O_DOWN), FSTRIDE * 2, 5632, 5632, 44, 4, c.at<int>(WS_ROUTE + 384 * 1024), c.at<int>(WS_ROUTE + 704 * 1024), c.at<int>(WS_ROUTE + 705 * 1024), c.G, c.bx, false};
    fe::EpiF32 E{c.at<float>(WS_Y), 1024};
    fg::gemm_stream<fe::SchedMoe, fe::EpiF32, false>(c.lds, S, E);
}
__device__ __forceinline__ void ph_attn(const Ctx& c, int l, int which  ) {
    const FP& p = *c.p; const int wid = c.wave;
    if (which & 2) {
        for (int k = 0; k < 2; ++k) { const int u = c.vcu * 2 + k; if (u >= 512) break; const int bh = u >> 4, b = bh >> 3, hq = bh & 7, qb = u & 15; const size_t qrow = (size_t)b * SEQ + qb * 256 + 32 * wid;
            fa::AttnArgs a{}; a.Qw = c.at<bf16>(WS_BQ) + qrow * 512 + hq * 64; a.pitchQ = 512; a.K1 = c.at<bf16>(WS_BK) + (size_t)b * SEQ * 128 + (hq >> 2) * 64; a.pitchK1 = 128; a.K2 = nullptr; a.pitchK2 = 0;
            a.V = c.at<bf16>(WS_BV) + (size_t)b * SEQ * 128 + (hq >> 2) * 64; a.pitchV = 128; a.Ow = c.at<bf16>(WS_YB) + qrow * 512 + hq * 64; a.pitchO = 512; a.NT = 64;
            fa::attn_unit<64, 0, 64, false>(c.lds, a); }
    }
    if (which & 4) {
        const int u = c.vcu; if (u < 256) { const int b = u >> 6, h = (u >> 4) & 3, qb = u & 15; const size_t qrow = (size_t)b * SEQ + qb * 256 + 32 * wid;
            fa::AttnArgs a{}; a.Qw = c.at<bf16>(WS_CQ) + qrow * 384 + h * 96; a.pitchQ = 384; a.K1 = c.at<bf16>(WS_CK) + (size_t)b * SEQ * 256 + h * 64; a.pitchK1 = 256; a.K2 = c.at<bf16>(WS_KPE) + (size_t)b * SEQ * 32; a.pitchK2 = 32;
            a.V = c.at<bf16>(WS_CV) + (size_t)b * SEQ * 256 + h * 64; a.pitchV = 256; a.Ow = c.at<bf16>(WS_YC) + qrow * 256 + h * 64; a.pitchO = 256; a.NT = 64;
            fa::attn_unit<64, 32, 64, false>(c.lds, a); }
    }
    if (which & 1) {
        const int u = c.vcu; if (u < 256) { const int b = u >> 6, h = (u >> 4) & 3, R0 = 4 * (u & 15);
            LAS float* rpbs = (LAS float*)(c.lds + EPI_OFF); const float* rpb = p.in[5] + (size_t)(l * 4 + h) * 15 * 31;
            if (c.tid < 480) { const int dr = c.tid >> 5, dc = c.tid & 31; rpbs[c.tid] = (dc < 31) ? rpb[dr * 31 + dc] * LOG2E : 0.f; }
            int krf = R0 - 4; krf = krf < 0 ? 0 : (krf > 56 ? 56 : krf); int krl = R0 + 3 - 4; krl = krl < 0 ? 0 : (krl > 56 ? 56 : krl); krl += 7;
            const int r = R0 + (wid >> 1); int w0 = r - 4; w0 = w0 < 0 ? 0 : (w0 > 56 ? 56 : w0);
            const size_t qrow = (size_t)b * SEQ + r * 64 + 32 * (wid & 1);
            fa::AttnArgs a{}; a.Qw = c.at<bf16>(WS_AQ) + qrow * 256 + h * 64; a.pitchQ = 256; a.K1 = c.at<bf16>(WS_AK) + ((size_t)b * SEQ + krf * 64) * 256 + h * 64; a.pitchK1 = 256; a.K2 = nullptr; a.pitchK2 = 0;
            a.V = c.at<bf16>(WS_AV) + ((size_t)b * SEQ + krf * 64) * 256 + h * 64; a.pitchV = 256; a.Ow = c.at<bf16>(WS_YA) + qrow * 256 + h * 64; a.pitchO = 256; a.NT = krl - krf + 1;
            a.t_lo = w0 - krf; a.t_hi = w0 - krf + 8; a.dr0 = krf - r + 7; a.cq0 = 32 * (wid & 1); a.rpbs = rpbs;
            fa::attn_unit<64, 0, 64, true>(c.lds, a); }
    }
}

__device__ __forceinline__ Ctx make_ctx(const FP& p, unsigned char* lds) {
    Ctx c; c.lds = (LAS unsigned char*)lds; c.tid = threadIdx.x; c.lane = c.tid & 63; c.wave = __builtin_amdgcn_readfirstlane(c.tid >> 6); c.G = gridDim.x; c.bx = blockIdx.x;
    c.vcu = (c.G % 8 == 0) ? (c.bx % 8) * (c.G / 8) + c.bx / 8 : c.bx; c.ws = p.ws; c.p = &p; return c;
}
template <int PH> __device__ __forceinline__ void run_phase(const Ctx& c, int l) {
    const FP& p = *c.p; const int i = l >> 1;
    if constexpr (PH == 0) ph_convert(c);
    else if constexpr (PH == 1) ph_ln(c, 0, p.in[2], p.in[3], false, nullptr, false);
    else if constexpr (PH == 2) ph_memkv(c);
    else if constexpr (PH == 3) ph_inproj(c, l);
    else if constexpr (PH == 4) ph_mla(c, l);
    else if constexpr (PH == 5) ph_attn(c, l, 7);
    else if constexpr (PH == 6) ph_merge(c, l);
    else if constexpr (PH == 7) ph_proj_pre(c, WS_MERGED, l * LSTRIDE + O_WOUT);
    else if constexpr (PH == 8) ph_ln(c, 1, p.in[19] + (size_t)(l * 3 + 0) * D, p.in[20] + (size_t)(l * 3 + 0) * D, false, nullptr, false);
    else if constexpr (PH == 9) ph_xq(c, l);
    else if constexpr (PH == 10) ph_xs(c, l);
    else if constexpr (PH == 11) ph_xo(c, l);
    else if constexpr (PH == 12) ph_proj_pre(c, WS_XO, l * LSTRIDE + O_WO);
    else if constexpr (PH == 13) ph_ln(c, 1, p.in[19] + (size_t)(l * 3 + 1) * D, p.in[20] + (size_t)(l * 3 + 1) * D, (l & 1) != 0, p.in[23] + (size_t)i * D * NE, false);
    else if constexpr (PH == 14) ph_ffn1(c, i);
    else if constexpr (PH == 15) ph_ffn2(c, i);
    else if constexpr (PH == 16) ph_ln(c, 1, p.in[19] + (size_t)(l * 3 + 2) * D, p.in[20] + (size_t)(l * 3 + 2) * D, false, nullptr, l == DEPTH - 1);
    else if constexpr (PH == 17) ph_moe_count(c);
    else if constexpr (PH == 18) ph_moe_assign(c);
    else if constexpr (PH == 19) ph_moe1(c, i);
    else if constexpr (PH == 20) ph_moe2(c, i);
    else if constexpr (PH == 21) ph_ln(c, 2, p.in[19] + (size_t)(l * 3 + 2) * D, p.in[20] + (size_t)(l * 3 + 2) * D, false, nullptr, l == DEPTH - 1);
}
template <int PH> __global__ void __launch_bounds__(NWAVES * 64, 2) k_fast(FP p) {
    extern __shared__ __attribute__((aligned(16))) unsigned char lds[];
    const Ctx c = make_ctx(p, lds);
    run_phase<PH>(c, p.l);
}
struct Ptrs {
    const float *x, *mem, *emb_g, *emb_b, *w_in, *rpb, *gqn, *gkn, *mqn, *mkvn, *wuq, *wukv, *wpa, *wpb, *wpc, *wout, *mwq, *mwkv, *mwo, *ln_g, *ln_b, *fgu, *fdown, *mrouter, *mgu, *mdown;
    float* out; unsigned char* ws;
};
static inline Ptrs make_ptrs(void* const* d_in, void* d_out, void* d_ws) {
    Ptrs P; const float* const* in = (const float* const*)d_in;
    P.x = in[0]; P.mem = in[1]; P.emb_g = in[2]; P.emb_b = in[3]; P.w_in = in[4]; P.rpb = in[5]; P.gqn = in[6]; P.gkn = in[7]; P.mqn = in[8]; P.mkvn = in[9]; P.wuq = in[10]; P.wukv = in[11];
    P.wpa = in[12]; P.wpb = in[13]; P.wpc = in[14]; P.wout = in[15]; P.mwq = in[16]; P.mwkv = in[17]; P.mwo = in[18]; P.ln_g = in[19]; P.ln_b = in[20]; P.fgu = in[21]; P.fdown = in[22];
    P.mrouter = in[23]; P.mgu = in[24]; P.mdown = in[25]; P.out = (float*)d_out; P.ws = (unsigned char*)d_ws; return P;
}
#define WSP(type, off) ((type*)(P.ws + (off)))

static void ngemm(hipStream_t s, int mode, const bf16* A, int lda, const float* W, int ldw, int M, int N, int K, float* C, bf16* Cb, int ldc,
                  const int* rowidx = nullptr, const int* segbase = nullptr, const int* segcnt = nullptr, size_t wstride = 0) {
    nv::NG p{}; p.A = A; p.lda = lda; p.rowidx = rowidx; p.segbase = segbase; p.segcnt = segcnt; p.W = W; p.wstride = wstride; p.ldw = ldw; p.C = C; p.Cb = Cb; p.ldc = ldc; p.M = M; p.N = N; p.K = K;
    dim3 g((N + 63) / 64, M / 64);
    if (mode) hipLaunchKernelGGL(nv::k_gemm<1>, g, dim3(256), 0, s, p); else hipLaunchKernelGGL(nv::k_gemm<0>, g, dim3(256), 0, s, p);
}

struct NaiveCtx {
    Ptrs P; hipStream_t s;
    float *hf, *zf, *ssq_q, *ssq_kv, *cosb, *sinb, *cosc, *sinc, *y, *f, *rw; bf16 *hb, *aq, *ak, *av, *bq, *bk, *bv, *cdq, *cdkv, *kpe, *gates, *cq, *ck, *cv, *ya, *yb, *yc, *merged, *xq, *xo, *memb, *memk, *memvt, *act;
    int *re, *tslot, *list, *cnt, *segbase, *segcnt;
    void init(const Ptrs& P_, hipStream_t s_) {
        P = P_; s = s_;
        hf = WSP(float, WS_HF); zf = WSP(float, WS_ZF); ssq_q = WSP(float, WS_SSQQ); ssq_kv = WSP(float, WS_SSQKV);
        cosb = WSP(float, WS_TAB); sinb = cosb + 1024; cosc = cosb + 2048; sinc = cosb + 2560; y = WSP(float, WS_Y); f = WSP(float, WS_F);
        hb = WSP(bf16, WS_HB); aq = WSP(bf16, WS_AQ); ak = WSP(bf16, WS_AK); av = WSP(bf16, WS_AV); bq = WSP(bf16, WS_BQ); bk = WSP(bf16, WS_BK); bv = WSP(bf16, WS_BV);
        cdq = WSP(bf16, WS_CDQ); cdkv = WSP(bf16, WS_CDKV); kpe = WSP(bf16, WS_KPE); gates = WSP(bf16, WS_GATES); cq = WSP(bf16, WS_CQ); ck = WSP(bf16, WS_CK); cv = WSP(bf16, WS_CV);
        ya = WSP(bf16, WS_YA); yb = WSP(bf16, WS_YB); yc = WSP(bf16, WS_YC); merged = WSP(bf16, WS_MERGED); xq = WSP(bf16, WS_XQ); xo = WSP(bf16, WS_XO);
        memb = WSP(bf16, WS_MEMB); memk = WSP(bf16, WS_MEMK); memvt = WSP(bf16, WS_MEMVT); act = WSP(bf16, WS_ACT);
        re = WSP(int, WS_ROUTE); rw = WSP(float, WS_ROUTE + 128 * 1024); tslot = WSP(int, WS_ROUTE + 256 * 1024); list = WSP(int, WS_ROUTE + 384 * 1024);
        cnt = WSP(int, WS_ROUTE + 640 * 1024); segbase = WSP(int, WS_ROUTE + 704 * 1024); segcnt = WSP(int, WS_ROUTE + 705 * 1024);
    }
    void tables() { hipLaunchKernelGGL(nv::k_rope_tab, dim3(4), dim3(256), 0, s, cosb, sinb, cosc, sinc); }
    void embed_ln() { hipLaunchKernelGGL(nv::k_ln, dim3(T / 4), dim3(256), 0, s, P.x, 1.0f, (const float*)nullptr, P.emb_g, P.emb_b, hf, (float*)nullptr, hb); }
    void memkv() {
        hipLaunchKernelGGL(nv::k_cvt_bf16, dim3(1024 * 1024 / 256), dim3(256), 0, s, P.mem, memb);
        for (int l = 0; l < DEPTH; ++l) { ngemm(s, 0, memb, D, P.mwkv + (size_t)l * D * 2 * D, 2 * D, 1024, 2 * D, D, zf, nullptr, 2 * D);
            hipLaunchKernelGGL(nv::k_memkv_epi, dim3(1024 * 1024 / 256), dim3(256), 0, s, (const float*)zf, memk + (size_t)l * 1024 * 1024, memvt + (size_t)l * 1024 * 1024); }
    }
    void inproj(int l) {
        ngemm(s, 0, hb, D, P.w_in + (size_t)l * D * INC, INC, T, INC, D, zf, nullptr, INC);
        nv::InEpi e{zf, aq, ak, av, bq, bk, bv, cdq, cdkv, kpe, gates, ssq_q, ssq_kv, P.gqn + l * 64, P.gkn + l * 64, P.mqn + l * 256, P.mkvn + l * 128, cosb, sinb, cosc, sinc};
        hipLaunchKernelGGL(nv::k_inproj_epi, dim3(T), dim3(256), 0, s, e);
    }
    void mla_up(int l) {
        float* qcf = zf; float* kvcf = zf + (size_t)8 * MiB;
        ngemm(s, 0, cdq, 256, P.wuq + (size_t)l * 256 * 384, 384, T, 384, 256, qcf, nullptr, 384);
        ngemm(s, 0, cdkv, 128, P.wukv + (size_t)l * 128 * 512, 512, T, 512, 128, kvcf, nullptr, 512);
        nv::MlaEpi e{qcf, kvcf, ssq_q, ssq_kv, cq, ck, cv, cosc, sinc};
        hipLaunchKernelGGL(nv::k_mla_epi, dim3(T), dim3(256), 0, s, e);
    }
    void attn_a(int l) { hipLaunchKernelGGL(nv::k_natten, dim3(SEQ / 256, 4, NBATCH), dim3(256), 0, s, (const bf16*)aq, (const bf16*)ak, (const bf16*)av, P.rpb + (size_t)l * 4 * 15 * 31, ya); }
    void attn_b(int) { hipLaunchKernelGGL((nv::k_attn<64, 0, 64, 8, 4>), dim3(SEQ / 256, 8, NBATCH), dim3(256), 0, s, (const bf16*)bq, (const bf16*)bk, (const bf16*)nullptr, (const bf16*)bv, yb); }
    void attn_c(int) { hipLaunchKernelGGL((nv::k_attn<64, 32, 64, 4, 1>), dim3(SEQ / 256, 4, NBATCH), dim3(256), 0, s, (const bf16*)cq, (const bf16*)ck, (const bf16*)kpe, (const bf16*)cv, yc); }
    void merge(int l) {
        float* pa = zf; float* pb = zf + (size_t)T * D; float* pc = zf + (size_t)2 * T * D;
        ngemm(s, 0, ya, 256, P.wpa + (size_t)l * 256 * D, D, T, D, 256, pa, nullptr, D);
        ngemm(s, 0, yb, 512, P.wpb + (size_t)l * 512 * D, D, T, D, 512, pb, nullptr, D);
        ngemm(s, 0, yc, 256, P.wpc + (size_t)l * 256 * D, D, T, D, 256, pc, nullptr, D);
        hipLaunchKernelGGL(nv::k_merge, dim3(T * D / 256), dim3(256), 0, s, (const float*)pa, (const float*)pb, (const float*)pc, (const bf16*)gates, merged);
    }
    void ln(int l, int which, bool last) { const float* add = f;
        hipLaunchKernelGGL(nv::k_ln, dim3(T / 4), dim3(256), 0, s, (const float*)hf, ALPHA, add, P.ln_g + (size_t)(l * 3 + which) * D, P.ln_b + (size_t)(l * 3 + which) * D, hf, last ? P.out : (float*)nullptr, hb);
    }
    void outproj(int l) { ngemm(s, 0, merged, D, P.wout + (size_t)l * D * D, D, T, D, D, f, nullptr, D); }
    void xq_proj(int l) { ngemm(s, 0, hb, D, P.mwq + (size_t)l * D * D, D, T, D, D, zf, nullptr, D); hipLaunchKernelGGL(nv::k_scale_bf16, dim3(T * D / 256), dim3(256), 0, s, (const float*)zf, C2_X, xq); }
    void xattn(int l) {
        hipLaunchKernelGGL(nv::k_xattn_s, dim3(T, 4), dim3(256), 0, s, (const bf16*)xq, (const bf16*)(memk + (size_t)l * 1024 * 1024), zf);
        hipLaunchKernelGGL(nv::k_xattn_o, dim3(T, 4), dim3(256), 0, s, (const float*)zf, (const bf16*)(memvt + (size_t)l * 1024 * 1024), xo);
    }
    void xo_proj(int l) { ngemm(s, 0, xo, D, P.mwo + (size_t)l * D * D, D, T, D, D, f, nullptr, D); }
    void ffn_dense(int l) {
        const int i = l / 2;
        ngemm(s, 1, hb, D, P.fgu + (size_t)i * D * 2 * DFF, 2 * DFF, T, DFF, D, nullptr, act, DFF);
        ngemm(s, 0, act, DFF, P.fdown + (size_t)i * DFF * D, D, T, D, DFF, f, nullptr, D);
    }
    void router(int l) { const int i = l / 2; hipLaunchKernelGGL(nv::k_router, dim3(T / 4), dim3(256), 0, s, (const float*)hf, P.mrouter + (size_t)i * D * NE, re, rw); }
    void moe_assign() {
        hipLaunchKernelGGL(nv::k_moe_count, dim3(T / 64), dim3(64), 0, s, (const int*)re, cnt);
        hipLaunchKernelGGL(nv::k_moe_assign, dim3(T / 64), dim3(64), 0, s, (const int*)re, (const int*)cnt, segbase, segcnt, list, tslot);
    }
    void moe_ffn(int l) {
        const int i = l / 2;
        ngemm(s, 1, hb, D, P.mgu + (size_t)i * NE * D * 2 * DFF, 2 * DFF, NSLOT, DFF, D, nullptr, act, DFF, list, segbase, segcnt, (size_t)D * 2 * DFF);
        ngemm(s, 0, act, DFF, P.mdown + (size_t)i * NE * DFF * D, D, NSLOT, D, DFF, y, nullptr, D, nullptr, segbase, segcnt, (size_t)DFF * D);
        hipLaunchKernelGGL(nv::k_moe_combine, dim3(T * D / 256), dim3(256), 0, s, (const float*)y, (const int*)tslot, (const float*)rw, f);
    }
};
#ifndef FASTMASK
#define FASTMASK 0x1ff
#endif
template <int PH> static void launch_fast(hipStream_t s, FP p, int l) {
    static bool attr = false;
    if (!attr) { (void)hipFuncSetAttribute((const void*)k_fast<PH>, hipFuncAttributeMaxDynamicSharedMemorySize, LDS_BYTES); attr = true; }
    p.l = l; hipLaunchKernelGGL(k_fast<PH>, dim3(256), dim3(NWAVES * 64), LDS_BYTES, s, p);
}
extern "C" void kernel_launch(void* const* d_in, const int* in_sizes, int n_in, void* d_out, int out_size, void* d_ws, size_t ws_size, hipStream_t stream) {
    if (n_in != 26 || out_size != T * D || ws_size < WS_END) { fprintf(stderr, "kernel_launch: unexpected shapes (n_in %d out %d ws %zu)\n", n_in, out_size, ws_size); return; }
    Ptrs P = make_ptrs(d_in, d_out, d_ws);
    (void)hipMemsetAsync((char*)d_ws + WS_CTL, 0, CTL_ZERO_BYTES, stream);
    NaiveCtx N; N.init(P, stream);
    FP fp{}; for (int i = 0; i < 26; ++i) fp.in[i] = (const float*)d_in[i]; fp.out = (float*)d_out; fp.ws = (unsigned char*)d_ws; fp.l = 0; fp.pad = 0;
    constexpr unsigned FM = FASTMASK;
    constexpr bool F_PROJ = FM & 1, F_LN = FM & 2, F_IN = FM & 4, F_MLA = FM & 8, F_ATT = FM & 16, F_MRG = FM & 32, F_X = FM & 64, F_FFN = FM & 128, F_MOE = FM & 256;
    if (FM) launch_fast<0>(stream, fp, 0);
    if (!FM) N.tables();
    if (F_LN) launch_fast<1>(stream, fp, 0); else N.embed_ln();
    if (F_X) launch_fast<2>(stream, fp, 0); else N.memkv();
    for (int l = 0; l < DEPTH; ++l) {
        const bool last = (l == DEPTH - 1), odd = (l & 1) != 0;
        if (F_IN) launch_fast<3>(stream, fp, l); else N.inproj(l);
        if (F_MLA) launch_fast<4>(stream, fp, l); else N.mla_up(l);
        if (F_ATT) launch_fast<5>(stream, fp, l); else { N.attn_a(l); N.attn_b(l); N.attn_c(l); }
        if (F_MRG) launch_fast<6>(stream, fp, l); else N.merge(l);
        if (F_PROJ) launch_fast<7>(stream, fp, l); else N.outproj(l);
        if (F_LN) launch_fast<8>(stream, fp, l); else N.ln(l, 0, false);
        if (F_PROJ) launch_fast<9>(stream, fp, l); else N.xq_proj(l);
        if (F_X) { launch_fast<10>(stream, fp, l); launch_fast<11>(stream, fp, l); } else N.xattn(l);
        if (F_PROJ) launch_fast<12>(stream, fp, l); else N.xo_proj(l);
        if (F_LN) launch_fast<13>(stream, fp, l); else { N.ln(l, 1, false); if (odd) N.router(l); }
        if (!odd) {
            if (F_FFN) { launch_fast<14>(stream, fp, l); launch_fast<15>(stream, fp, l); } else N.ffn_dense(l);
            if (F_LN) launch_fast<16>(stream, fp, l); else N.ln(l, 2, last);
        } else {
            if (F_MOE) { launch_fast<17>(stream, fp, l); launch_fast<18>(stream, fp, l); launch_fast<19>(stream, fp, l); launch_fast<20>(stream, fp, l); } else { N.moe_assign(); N.moe_ffn(l); }
            if (F_LN) launch_fast<21>(stream, fp, l); else N.ln(l, 2, last);
        }
    }
}
```

```cpp
#include <hip/hip_runtime.h>
#include <cstdio>
#include <cstdint>
#include <cmath>

typedef unsigned short bf16;
constexpr int T = 16384, D = 1024, SEQ = 4096, NBATCH = 4, DEPTH = 4, INC = 5024, DFF = 2816, NE = 8, MEMLEN = 256;
constexpr int NSLOT = 2 * T + 2048;
constexpr float LOG2E = 1.4426950408889634f;
constexpr float C2_A = 0.125f * LOG2E, C2_B = 0.125f * LOG2E, C2_C = 0.10206207261596577f * LOG2E, C2_X = 0.0625f * LOG2E;
constexpr float ALPHA = 1.681792830507429f;

__host__ __device__ __forceinline__ unsigned f2bf(float f) { unsigned u = __builtin_bit_cast(unsigned, f); return (u + 0x7fffu + ((u >> 16) & 1u)) >> 16; }
__host__ __device__ __forceinline__ float bf2f(bf16 b) { return __builtin_bit_cast(float, (unsigned)b << 16); }

constexpr size_t MiB = 1u << 20;
constexpr size_t WS_CTL = 0, CTL_ZERO_BYTES = 1 * MiB;
constexpr size_t WS_TAB = 1 * MiB;
constexpr size_t WS_ROUTE = 2 * MiB;
constexpr size_t WS_SSQQ = 3 * MiB, WS_SSQKV = 3 * MiB + 256 * 1024;
constexpr size_t WS_KPE = 4 * MiB, WS_MEMB = 5 * MiB, WS_MEMK = 7 * MiB, WS_MEMVT = 15 * MiB;
constexpr size_t WS_HF = 24 * MiB, WS_HB = 88 * MiB;
constexpr size_t WS_AQ = 120 * MiB, WS_AK = 128 * MiB, WS_AV = 136 * MiB, WS_BQ = 144 * MiB, WS_BK = 160 * MiB, WS_BV = 164 * MiB;
constexpr size_t WS_CDQ = 168 * MiB, WS_CDKV = 176 * MiB, WS_CQ = 180 * MiB, WS_CK = 192 * MiB, WS_CV = 200 * MiB;
constexpr size_t WS_YA = 208 * MiB, WS_YB = 216 * MiB, WS_YC = 232 * MiB, WS_GATES = 240 * MiB, WS_MERGED = 336 * MiB;
constexpr size_t WS_XQ = 368 * MiB, WS_XO = 400 * MiB;
constexpr size_t WS_ACT = 432 * MiB, WS_Y = 620 * MiB, WS_F = 760 * MiB;
constexpr size_t WS_ZF = 432 * MiB;
constexpr size_t WS_WEIGHTS = 832 * MiB;
constexpr size_t WS_END = 1232 * MiB;
#define GAS __attribute__((address_space(1)))
#define LAS __attribute__((address_space(3)))
typedef unsigned v4u __attribute__((ext_vector_type(4)));
typedef unsigned v2u __attribute__((ext_vector_type(2)));
typedef float f32x4 __attribute__((ext_vector_type(4)));
typedef float f32x2 __attribute__((ext_vector_type(2)));
typedef float f32x16 __attribute__((ext_vector_type(16)));
typedef short bf16x8 __attribute__((ext_vector_type(8)));
typedef short s16x4 __attribute__((ext_vector_type(4)));
typedef GAS unsigned gu32;
#define RLX_AGENT __ATOMIC_RELAXED, __HIP_MEMORY_SCOPE_AGENT
#define LDS_WAIT() asm volatile("s_waitcnt lgkmcnt(0)" ::: "memory")
#define VM_WAIT() asm volatile("s_waitcnt vmcnt(0)" ::: "memory")
#ifdef DBG_NOSWZ
template <int X> __device__ __forceinline__ float swz_xor(float v) { return __shfl_xor(v, X); }
#else
template <int X> __device__ __forceinline__ float swz_xor(float v) { return __builtin_bit_cast(float, __builtin_amdgcn_ds_swizzle(__builtin_bit_cast(int, v), (X << 10) | 0x1f)); }
#endif
#ifdef DBG_NOSWZ
template <int X> __device__ __forceinline__ int swz_xor_i(int v) { return __shfl_xor(v, X); }
#else
template <int X> __device__ __forceinline__ int swz_xor_i(int v) { return __builtin_amdgcn_ds_swizzle(v, (X << 10) | 0x1f); }
#endif
__device__ __forceinline__ void swap32(unsigned v, unsigned& r0, unsigned& r1) { unsigned w = v; asm volatile("" : "+v"(w)); auto rr = __builtin_amdgcn_permlane32_swap(v, w, false, false); r0 = rr[0]; r1 = rr[1]; }
__device__ __forceinline__ float xor32_add(float v) { unsigned a, b; swap32(__builtin_bit_cast(unsigned, v), a, b); return __builtin_bit_cast(float, a) + __builtin_bit_cast(float, b); }
__device__ __forceinline__ float xor32_max(float v) { unsigned a, b; swap32(__builtin_bit_cast(unsigned, v), a, b); return fmaxf(__builtin_bit_cast(float, a), __builtin_bit_cast(float, b)); }
__device__ __forceinline__ int xor32_add_i(int v) { unsigned a, b; swap32((unsigned)v, a, b); return (int)a + (int)b; }
__device__ __forceinline__ int lane_id_opaque() { unsigned m = ~0u; asm volatile("" : "+s"(m)); return (int)__builtin_amdgcn_mbcnt_hi(m, __builtin_amdgcn_mbcnt_lo(m, 0u)); }
__device__ __forceinline__ int uload_i(const int* q) { return __builtin_amdgcn_readfirstlane(__hip_atomic_load(q, __ATOMIC_RELAXED, __HIP_MEMORY_SCOPE_AGENT)); }
__device__ __forceinline__ float uload_f(const float* q) { return __builtin_bit_cast(float, __builtin_amdgcn_readfirstlane(__hip_atomic_load((const int*)q, __ATOMIC_RELAXED, __HIP_MEMORY_SCOPE_AGENT))); }
constexpr int NWAVES = 8;
constexpr int RING_BYTES = 131072;
constexpr int EPI_OFF = RING_BYTES;
constexpr int EPI_BYTES = 24576;
constexpr int MISC_OFF = EPI_OFF + EPI_BYTES;
constexpr int LDS_BYTES = MISC_OFF + 256;

#define XB_TMO      128
#define XB_XCNT(j)  (256  + 64 * (j))
#define XB_XSUB(j)  (1280 + 64 * (j))
#define XB_XGEN(j)  (2304 + 64 * (j))
#define XB_TOP      3328
#define XB_TOPGEN   3392
#define XCD_BAR_WORDS 3456
#define XB_SPIN_CAP (1u << 18)

__device__ __forceinline__ unsigned xb_ld(unsigned* p)              { return __hip_atomic_load(p, __ATOMIC_RELAXED, __HIP_MEMORY_SCOPE_AGENT); }
__device__ __forceinline__ unsigned xb_add(unsigned* p, unsigned v) { return __hip_atomic_fetch_add(p, v, __ATOMIC_RELAXED, __HIP_MEMORY_SCOPE_AGENT); }
__device__ __forceinline__ unsigned xb_xcc_id() { return (unsigned)__builtin_amdgcn_s_getreg((3 << 11) | 20) & 0xFu; }
#define XB_SPIN(cond, bar) do { unsigned _sp = 0; while (cond) { __builtin_amdgcn_s_sleep(1); \
    if ((++_sp & 255u) == 0u) { if (xb_ld(&(bar)[XB_TMO])) break; if (_sp > XB_SPIN_CAP) { atomicAdd(&(bar)[XB_TMO], 1u); break; } } } } while (0)

struct XcdBarrier {
    unsigned* bar; unsigned x;
    volatile LAS unsigned* st;
};

__device__ __forceinline__ XcdBarrier xcd_barrier_post(unsigned* bar, volatile LAS unsigned* st) {
    XcdBarrier b; b.bar = bar; b.x = xb_xcc_id(); b.st = st;
    if (threadIdx.x == 0) (void)xb_add(&bar[XB_XCNT(b.x)], 1u);
    return b;
}
__device__ __forceinline__ void xcd_barrier_complete(unsigned* bar, unsigned x, unsigned& nloc, unsigned& nx) {
    const unsigned G = gridDim.x * gridDim.y * gridDim.z;
    unsigned sum, cnt, mine, sp = 0u;
    for (;;) {
        sum = 0u; cnt = 0u; mine = 0u;
#pragma unroll
        for (unsigned j = 0; j < 16; ++j) { const unsigned c = xb_ld(&bar[XB_XCNT(j)]); sum += c; cnt += (c > 0u) ? 1u : 0u; mine = (j == x) ? c : mine; }
        if (sum == G) break;
        __builtin_amdgcn_s_sleep(1);
        if ((++sp & 255u) == 0u) { if (xb_ld(&bar[XB_TMO])) break; if (sp > XB_SPIN_CAP) { atomicAdd(&bar[XB_TMO], 1u); break; } }
    }
    nloc = mine > 0u ? mine : 1u; nx = cnt > 0u ? cnt : 1u;
}

__device__ __forceinline__ void xcd_barrier(const XcdBarrier& b) {
    asm volatile("s_waitcnt vmcnt(0)" ::: "memory");
    __syncthreads();
    unsigned* bar_o; { const unsigned long long v_ = (unsigned long long)b.bar; unsigned lo_ = (unsigned)v_, hi_ = (unsigned)(v_ >> 32); asm volatile("" : "+s"(lo_), "+s"(hi_)); bar_o = (unsigned*)(((unsigned long long)hi_ << 32) | lo_); }
    unsigned bx_o = b.x; asm volatile("" : "+s"(bx_o));
    if (threadIdx.x == 0) {
        unsigned* bar = bar_o;
        __builtin_amdgcn_s_waitcnt(0);
        unsigned nloc = b.st[0], nx = b.st[1];
        if (nloc == 0u) { xcd_barrier_complete(bar, bx_o, nloc, nx); b.st[0] = nloc; b.st[1] = nx; }
        const unsigned old = xb_add(&bar[XB_XSUB(bx_o)], 1u);
        const unsigned gen = old / nloc;
        if (old + 1u == (gen + 1u) * nloc) {
            __builtin_amdgcn_fence(__ATOMIC_RELEASE, "agent");
            asm volatile("s_waitcnt vmcnt(0)" ::: "memory");
            const unsigned og = xb_add(&bar[XB_TOP], 1u);
            const unsigned tg = og / nx;
            if (og + 1u == (tg + 1u) * nx) xb_add(&bar[XB_TOPGEN], 1u);
            else XB_SPIN(xb_ld(&bar[XB_TOPGEN]) == tg, bar);
            __builtin_amdgcn_fence(__ATOMIC_ACQUIRE, "agent");
            xb_add(&bar[XB_XGEN(bx_o)], 1u);
            asm volatile("s_waitcnt vmcnt(0)" ::: "memory");
        } else {
            XB_SPIN(xb_ld(&bar[XB_XGEN(bx_o)]) == gen, bar);
            __builtin_amdgcn_fence(__ATOMIC_ACQUIRE, "agent");
            asm volatile("s_waitcnt vmcnt(0)" ::: "memory");
        }
    }
    __syncthreads();
}

namespace fg {
constexpr int BM = 256, BK = 64, HALF = 128, HTB = HALF * BK * 2, STAGE_BYTES = 8 * HTB;
__host__ __device__ __forceinline__ int lds_byte(int r, int c) { const int st = (r >> 4) * 2 + (c >> 5), rr = r & 15, cc = c & 31, ob = rr * 64 + cc * 2; return st * 1024 + (ob ^ (((ob >> 9) & 1) << 5)); }
__host__ __device__ __forceinline__ void stage_rc(int b, int& R, int& C) { const int st = b / 1024, sb = b % 1024, swz = sb ^ (((sb >> 9) & 1) << 5); R = (st >> 1) * 16 + swz / 64; C = (st & 1) * 32 + (swz % 64) / 2; }
__host__ __device__ __forceinline__ int perm32(int rho) { const int n = rho >> 4, i = rho & 15; return 8 * (i >> 2) + 4 * n + (i & 3); }
__device__ __forceinline__ unsigned cvt_pk_bf16(float lo, float hi) { unsigned r; asm volatile("v_cvt_pk_bf16_f32 %0, %1, %2" : "=v"(r) : "v"(lo), "v"(hi)); return r; }

struct GUnit {
    const char* A; const char* B;
    unsigned lda2, ldb2;
    int nt;
    const int* gat; int gn;
    int carry;
    int kind, pm, pn, x0, x1;
};
typedef f32x4 Acc[2][2][4][2];

template <class Sched, class Epi, bool GATHER, bool VARY>
__device__ __forceinline__ void gemm_stream(LAS unsigned char* lds, const Sched& S, const Epi& E, int wave_) {
    int tid_ = wave_ * 64 + lane_id_opaque(); asm volatile("" : "+v"(tid_));
    const int tid = tid_, wid = __builtin_amdgcn_readfirstlane(tid >> 6), lane = tid & 63, wr = wid >> 2, wc = wid & 3, fr = lane & 15, fq = lane >> 4;
    int sR[2], sC2[2], sRb[2];
#pragma unroll
    for (int i = 0; i < 2; ++i) { int R, C; stage_rc(tid * 16 + i * 8192, R, C); sR[i] = R; sC2[i] = C * 2; sRb[i] = (R & ~31) + perm32(R & 31); }
    const unsigned ldsw = (unsigned)wid * 1024u;
    const int aoff = lds_byte(wr * 64 + fr, fq * 8), boff = lds_byte(wc * 32 + fr, fq * 8);
#define FG_SA(b, h) (((b) * 2 + (h)) * HTB)
#define FG_SB(b, h) ((4 + (b) * 2 + (h)) * HTB)
#define FG_STAGE(bufoff, gbase, v0, v1) do { \
        __builtin_amdgcn_global_load_lds((const unsigned*)((const char*)(gbase) + (v0)), (LAS unsigned*)(lds + (bufoff) + ldsw), 16, 0, 0); \
        __builtin_amdgcn_global_load_lds((const unsigned*)((const char*)(gbase) + (v1)), (LAS unsigned*)(lds + (bufoff) + ldsw + 8192), 16, 0, 0); } while (0)
#define FG_LDA(dst, b, h) do { _Pragma("unroll") for (int m = 0; m < 4; ++m) _Pragma("unroll") for (int k = 0; k < 2; ++k) dst[m][k] = *(const LAS bf16x8*)(lds + FG_SA(b, h) + aoff + m * 2048 + k * 1024); } while (0)
#define FG_LDB(dst, b, h) do { _Pragma("unroll") for (int n = 0; n < 2; ++n) _Pragma("unroll") for (int k = 0; k < 2; ++k) dst[n][k] = *(const LAS bf16x8*)(lds + FG_SB(b, h) + boff + n * 2048 + k * 1024); } while (0)
#define FG_MMA(ai, bj, At, Bt) do { __builtin_amdgcn_s_setprio(1); _Pragma("unroll") for (int m = 0; m < 4; ++m) _Pragma("unroll") for (int n = 0; n < 2; ++n) _Pragma("unroll") for (int k = 0; k < 2; ++k) \
        acc[ai][bj][m][n] = __builtin_amdgcn_mfma_f32_16x16x32_bf16(Bt[n][k], At[m][k], acc[ai][bj][m][n], 0, 0, 0); __builtin_amdgcn_s_setprio(0); } while (0)
#define FG_WAIT_V(n) asm volatile("s_waitcnt vmcnt(" #n ")" ::: "memory")
#define FG_WAIT_L(n) asm volatile("s_waitcnt lgkmcnt(" #n ")" ::: "memory")
#define FG_BAR __builtin_amdgcn_s_barrier()
#define FG_SCHED __builtin_amdgcn_sched_barrier(0)
#define FG_VOFF(u, vA, vB, hsA, hsB) do { \
        if constexpr (GATHER) { _Pragma("unroll") for (int h_ = 0; h_ < 2; ++h_) _Pragma("unroll") for (int i_ = 0; i_ < 2; ++i_) { const int r_ = sR[i_] + 128 * h_; const int tok_ = (r_ < (u).gn) ? (u).gat[r_] : 0; vA[h_][i_] = (unsigned)tok_ * (u).lda2 + (unsigned)sC2[i_]; } hsA = 0; } \
        else { _Pragma("unroll") for (int i_ = 0; i_ < 2; ++i_) { vA[0][i_] = (unsigned)sR[i_] * (u).lda2 + (unsigned)sC2[i_]; } hsA = (size_t)HALF * (u).lda2; } \
        _Pragma("unroll") for (int i_ = 0; i_ < 2; ++i_) vB[i_] = (unsigned)sRb[i_] * (u).ldb2 + (unsigned)sC2[i_]; hsB = (size_t)HALF * (u).ldb2; } while (0)
    GUnit cur, nxt; int ui = 0;
    if (!S.next(0, cur)) return;
    Acc acc;
#define FG_ZERO() do { _Pragma("unroll") for (int a = 0; a < 2; ++a) _Pragma("unroll") for (int b = 0; b < 2; ++b) _Pragma("unroll") for (int m = 0; m < 4; ++m) _Pragma("unroll") for (int n = 0; n < 2; ++n) acc[a][b][m][n] = (f32x4){0.f, 0.f, 0.f, 0.f}; } while (0)
    FG_ZERO();
    bf16x8 At[4][2], B0[2][2], B1[2][2];
    unsigned vAc[2][2], vBc[2], vAn[2][2], vBn[2]; size_t hsAc, hsBc, hsAn, hsBn;
    FG_VOFF(cur, vAc, vBc, hsAc, hsBc);
    const char* cA = cur.A; const char* cB = cur.B;
    FG_STAGE(FG_SB(0, 0), cB, vBc[0], vBc[1]); FG_STAGE(FG_SB(0, 1), cB + hsBc, vBc[0], vBc[1]); FG_STAGE(FG_SA(0, 0), cA, vAc[0][0], vAc[0][1]); FG_STAGE(FG_SA(0, 1), cA + hsAc, vAc[GATHER ? 1 : 0][0], vAc[GATHER ? 1 : 0][1]);
    if (wr == 1) FG_BAR;
    FG_WAIT_V(2); FG_BAR;
    FG_STAGE(FG_SB(1, 0), cB + 128, vBc[0], vBc[1]); FG_STAGE(FG_SA(1, 0), cA + 128, vAc[0][0], vAc[0][1]); FG_STAGE(FG_SB(1, 1), cB + hsBc + 128, vBc[0], vBc[1]);
    FG_WAIT_V(6); FG_BAR;
    for (;;) {
        const bool has_next = S.next(ui + 1, nxt);
        const char* nA = cA; const char* nB = cB;
        if (has_next) { nA = nxt.A; nB = nxt.B; }
        if constexpr (VARY) {
            if (has_next) { FG_VOFF(nxt, vAn, vBn, hsAn, hsBn); }
            else { _Pragma("unroll") for (int i_ = 0; i_ < 2; ++i_) { vAn[0][i_] = vAc[0][i_]; if constexpr (GATHER) vAn[1][i_] = vAc[1][i_]; vBn[i_] = vBc[i_]; } hsAn = hsAc; hsBn = hsBc; }
        }
        int nt = cur.nt; asm volatile("" : "+s"(nt));
        for (int t = 0; t < nt; t += 2) {
            const bool last = (t == nt - 2);
            const char* a1 = cA + (size_t)(t + 1) * 128;
            const char* a2 = last ? nA : cA + (size_t)(t + 2) * 128; const char* b2 = last ? nB : cB + (size_t)(t + 2) * 128;
            const char* a3 = a2 + 128; const char* b3 = b2 + 128;
            unsigned xA00 = vAc[0][0], xA01 = vAc[0][1], xA10 = vAc[GATHER ? 1 : 0][0], xA11 = vAc[GATHER ? 1 : 0][1], xB0 = vBc[0], xB1 = vBc[1]; size_t hA2 = hsAc, hB2 = hsBc;
            if constexpr (VARY) { if (last) { xA00 = vAn[0][0]; xA01 = vAn[0][1]; xA10 = vAn[GATHER ? 1 : 0][0]; xA11 = vAn[GATHER ? 1 : 0][1]; xB0 = vBn[0]; xB1 = vBn[1]; hA2 = hsAn; hB2 = hsBn; } }
            FG_LDB(B0, 0, 0); FG_LDB(B1, 0, 1); FG_SCHED; FG_LDA(At, 0, 0); FG_STAGE(FG_SA(1, 1), a1 + hsAc, vAc[GATHER ? 1 : 0][0], vAc[GATHER ? 1 : 0][1]);
            FG_WAIT_V(8); FG_WAIT_L(0); FG_BAR; FG_MMA(0, 0, At, B0); FG_MMA(0, 1, At, B1); FG_BAR; FG_SCHED;
            FG_LDA(At, 0, 1); FG_STAGE(FG_SB(0, 0), b2, xB0, xB1); FG_STAGE(FG_SB(0, 1), b2 + hB2, xB0, xB1); FG_STAGE(FG_SA(0, 0), a2, xA00, xA01);
            FG_WAIT_V(8); FG_WAIT_L(0); FG_BAR; FG_MMA(1, 0, At, B0); FG_MMA(1, 1, At, B1); FG_BAR; FG_SCHED;
            FG_LDB(B0, 1, 0); FG_LDB(B1, 1, 1); FG_SCHED; FG_LDA(At, 1, 0); FG_STAGE(FG_SA(0, 1), a2 + hA2, xA10, xA11);
            FG_WAIT_V(8); FG_WAIT_L(0); FG_BAR; FG_MMA(0, 0, At, B0); FG_MMA(0, 1, At, B1); FG_BAR; FG_SCHED;
            FG_LDA(At, 1, 1); FG_STAGE(FG_SB(1, 0), b3, xB0, xB1); FG_STAGE(FG_SB(1, 1), b3 + hB2, xB0, xB1); FG_STAGE(FG_SA(1, 0), a3, xA00, xA01);
            FG_WAIT_V(8); FG_WAIT_L(0); FG_BAR; FG_MMA(1, 0, At, B0); FG_MMA(1, 1, At, B1); FG_BAR; FG_SCHED;
        }
        if (wr == 0) FG_BAR;
        E(acc, cur, wr, wc, fr, fq, lds + EPI_OFF, wid, lane);
        if (!has_next) break;
        if (!nxt.carry) FG_ZERO();
        cur = nxt; cA = nA; cB = nB; ++ui;
        if constexpr (VARY) {
#pragma unroll
            for (int i_ = 0; i_ < 2; ++i_) { vAc[0][i_] = vAn[0][i_]; if constexpr (GATHER) vAc[1][i_] = vAn[1][i_]; vBc[i_] = vBn[i_]; }
            hsAc = hsAn; hsBc = hsBn; }
        if (wr == 1) FG_BAR;
    }
    FG_WAIT_V(0);
    FG_BAR;
}
}

namespace fe {
using fg::Acc; using fg::GUnit; using fg::cvt_pk_bf16;
__device__ __forceinline__ v4u pack8(f32x4 a, f32x4 b) { v4u w; w.x = cvt_pk_bf16(a[0], a[1]); w.y = cvt_pk_bf16(a[2], a[3]); w.z = cvt_pk_bf16(b[0], b[1]); w.w = cvt_pk_bf16(b[2], b[3]); return w; }
__device__ __forceinline__ f32x4 unpack_lo(v4u w) { f32x4 r; r[0] = __builtin_bit_cast(float, w.x << 16); r[1] = __builtin_bit_cast(float, w.x & 0xffff0000u); r[2] = __builtin_bit_cast(float, w.y << 16); r[3] = __builtin_bit_cast(float, w.y & 0xffff0000u); return r; }
__device__ __forceinline__ f32x4 unpack_hi(v4u w) { f32x4 r; r[0] = __builtin_bit_cast(float, w.z << 16); r[1] = __builtin_bit_cast(float, w.z & 0xffff0000u); r[2] = __builtin_bit_cast(float, w.w << 16); r[3] = __builtin_bit_cast(float, w.w & 0xffff0000u); return r; }
__device__ __forceinline__ float fsigmoid(float v) { return __builtin_amdgcn_rcpf(1.f + __builtin_amdgcn_exp2f(-v * LOG2E)); }

__device__ __forceinline__ bool static_order(int i, int G, int c, int nM, int nN, int& pm, int& pn) {
    const long L = (long)i * G + c; const int nwg = nM * nN; if (L >= nwg) return false;
    int wgid = (int)L; { const int q = nwg / 8, r = nwg % 8, xcd = wgid % 8, off = wgid / 8; wgid = (xcd < r ? xcd * (q + 1) : r * (q + 1) + (xcd - r) * q) + off; }
    const int nig = 8 * nN, gid = wgid / nig, fm = gid * 8, gsz = (nM - fm) < 8 ? (nM - fm) : 8;
    pm = fm + ((wgid % nig) % gsz); pn = (wgid % nig) / gsz; return true;
}
struct SchedT {
    const char* A; const char* B; unsigned lda2, ldb2; int nt, nM, nN, G, c;
    __device__ __forceinline__ bool next(int i, GUnit& u) const {
        int pm, pn; if (!static_order(i, G, c, nM, nN, pm, pn)) return false;
        u.A = A + (size_t)pm * 256 * lda2; u.B = B + (size_t)pn * 256 * ldb2; u.lda2 = lda2; u.ldb2 = ldb2; u.nt = nt; u.gat = nullptr; u.gn = 0; u.carry = 0; u.kind = 0; u.pm = pm; u.pn = pn; u.x0 = pm * 256; u.x1 = 0; return true;
    }
};
struct EpiF32 { float* C; int ldc;
    __device__ __forceinline__ void operator()(Acc& acc, const GUnit& u, int wr, int wc, int fr, int fq, LAS unsigned char*, int, int) const {
        const int row0 = u.x0 + wr * 64 + fr, col0 = u.x1 + u.pn * 256 + wc * 32 + 8 * fq;
#pragma unroll
        for (int ai = 0; ai < 2; ++ai)
#pragma unroll
            for (int m = 0; m < 4; ++m) { float* rp = C + (size_t)(row0 + ai * 128 + m * 16) * ldc + col0;
#pragma unroll
                for (int bj = 0; bj < 2; ++bj) { *(f32x4*)(rp + bj * 128) = acc[ai][bj][m][0]; *(f32x4*)(rp + bj * 128 + 4) = acc[ai][bj][m][1]; } }
    }
};
struct EpiBf16 { bf16* C; int ldc; float scale;
    __device__ __forceinline__ void operator()(Acc& acc, const GUnit& u, int wr, int wc, int fr, int fq, LAS unsigned char*, int, int) const {
        const int row0 = u.x0 + wr * 64 + fr, col0 = u.x1 + u.pn * 256 + wc * 32 + 8 * fq;
#pragma unroll
        for (int ai = 0; ai < 2; ++ai)
#pragma unroll
            for (int m = 0; m < 4; ++m) { bf16* rp = C + (size_t)(row0 + ai * 128 + m * 16) * ldc + col0;
#pragma unroll
                for (int bj = 0; bj < 2; ++bj) *(v4u*)(rp + bj * 128) = pack8(acc[ai][bj][m][0] * scale, acc[ai][bj][m][1] * scale); }
    }
};
struct EpiGated { bf16* C;
    __device__ __forceinline__ void operator()(Acc& acc, const GUnit& u, int wr, int wc, int fr, int fq, LAS unsigned char*, int, int) const {
        const int row0 = u.x0 + wr * 64 + fr, col0 = u.pn * 128 + wc * 32 + 8 * fq;
#pragma unroll
        for (int ai = 0; ai < 2; ++ai)
#pragma unroll
            for (int m = 0; m < 4; ++m) { f32x4 o[2];
#pragma unroll
                for (int n = 0; n < 2; ++n)
#pragma unroll
                    for (int e = 0; e < 4; ++e) { const float a = acc[ai][0][m][n][e]; o[n][e] = a * fsigmoid(a) * acc[ai][1][m][n][e]; }
                *(v4u*)(C + (size_t)(row0 + ai * 128 + m * 16) * DFF + col0) = pack8(o[0], o[1]); }
    }
};

struct EpiIn { unsigned char* ws0; const float *gqn0, *gkn0, *mqn0, *mkvn0;
    __device__ __forceinline__ void head_norm_rope(Acc& acc, int trow0, int fq, const float* gain, float scale, bf16* dst, int ldd, const float* cosb, const float* sinb) const {
        f32x4 g1[2], g2[2];
#pragma unroll
        for (int n = 0; n < 2; ++n) { g1[n] = *(const f32x4*)(gain + 8 * fq + 4 * n); g2[n] = *(const f32x4*)(gain + 32 + 8 * fq + 4 * n); }
#pragma unroll
        for (int ai = 0; ai < 2; ++ai)
#pragma unroll
            for (int m = 0; m < 4; ++m) { const int t = trow0 + ai * 128 + m * 16; const int pos = t & (SEQ - 1), tb = ((fq < 2) ? (pos >> 6) : (pos & 63)) * 16 + 8 * (fq & 1);
                float ss = 0.f;
#pragma unroll
                for (int bj = 0; bj < 2; ++bj)
#pragma unroll
                    for (int n = 0; n < 2; ++n) { const f32x4 x = acc[ai][bj][m][n]; ss += (x[0] * x[0] + x[1] * x[1]) + (x[2] * x[2] + x[3] * x[3]); }
                ss += swz_xor<16>(ss); ss = xor32_add(ss);
                const float r = rsqrtf(ss * (1.f / 64.f) + 1e-6f); f32x4 o1[2], o2[2];
#pragma unroll
                for (int n = 0; n < 2; ++n) { const f32x4 c = *(const f32x4*)(cosb + tb + 4 * n), s = *(const f32x4*)(sinb + tb + 4 * n);
                    const f32x4 x1 = acc[ai][0][m][n] * r * g1[n], x2 = acc[ai][1][m][n] * r * g2[n]; o1[n] = (x1 * c - x2 * s) * scale; o2[n] = (x2 * c + x1 * s) * scale; }
                bf16* rp = dst + (size_t)t * ldd + 8 * fq; *(v4u*)rp = pack8(o1[0], o1[1]); *(v4u*)(rp + 32) = pack8(o2[0], o2[1]); }
    }
    __device__ __forceinline__ void operator()(Acc& acc, const GUnit& u, int wr, int wc, int fr, int fq, LAS unsigned char*, int, int) const {
        const int pn = u.pn, trow0 = u.pm * 256 + wr * 64 + fr, cw = wc * 32 + 8 * fq;
        unsigned char* ws; { const unsigned long long v_ = (unsigned long long)ws0; unsigned lo_ = __builtin_amdgcn_readfirstlane((unsigned)v_), hi_ = __builtin_amdgcn_readfirstlane((unsigned)(v_ >> 32)); asm volatile("" : "+s"(lo_), "+s"(hi_)); ws = (unsigned char*)(((unsigned long long)hi_ << 32) | lo_); }
        bf16 *aq = (bf16*)(ws + WS_AQ), *ak = (bf16*)(ws + WS_AK), *av = (bf16*)(ws + WS_AV), *bq = (bf16*)(ws + WS_BQ), *bk = (bf16*)(ws + WS_BK), *bv = (bf16*)(ws + WS_BV), *cdq = (bf16*)(ws + WS_CDQ), *cdkv = (bf16*)(ws + WS_CDKV), *kpe = (bf16*)(ws + WS_KPE), *gates = (bf16*)(ws + WS_GATES);
        float *ssq_q = (float*)(ws + WS_SSQQ), *ssq_kv = (float*)(ws + WS_SSQKV); const float *cosb = (const float*)(ws + WS_TAB), *sinb = cosb + 1024, *cosc = cosb + 2048, *sinc = cosb + 2560;
        const float *gqn = gqn0, *gkn = gkn0, *mqn = mqn0, *mkvn = mkvn0;
        if (pn <= 2 || pn >= 8) {
            bf16* dst; int ldd; float sc = 1.f; if (pn == 0) { dst = aq; ldd = 256; sc = C2_A; } else if (pn == 1) { dst = ak; ldd = 256; } else if (pn == 2) { dst = av; ldd = 256; } else { dst = gates + (pn - 8) * 256; ldd = 3072; }
#pragma unroll
            for (int ai = 0; ai < 2; ++ai)
#pragma unroll
                for (int m = 0; m < 4; ++m) { bf16* rp = dst + (size_t)(trow0 + ai * 128 + m * 16) * ldd + cw;
#pragma unroll
                    for (int bj = 0; bj < 2; ++bj) { f32x4 a = acc[ai][bj][m][0], b = acc[ai][bj][m][1];
                        if (pn >= 8) {
#pragma unroll
                            for (int e = 0; e < 4; ++e) { a[e] = fsigmoid(a[e]); b[e] = fsigmoid(b[e]); } }
                        else { a = a * sc; b = b * sc; }
                        *(v4u*)(rp + bj * 128) = pack8(a, b); } }
        } else if (pn == 3 || pn == 4) { head_norm_rope(acc, trow0, fq, gqn, C2_B, bq + ((pn - 3) * 4 + wc) * 64, 512, cosb, sinb);
        } else if (pn == 5) {
            if (wc < 2) head_norm_rope(acc, trow0, fq, gkn, 1.f, bk + wc * 64, 128, cosb, sinb);
            else {
#pragma unroll
                for (int ai = 0; ai < 2; ++ai)
#pragma unroll
                    for (int m = 0; m < 4; ++m) { bf16* rp = bv + (size_t)(trow0 + ai * 128 + m * 16) * 128 + (wc - 2) * 64 + 8 * fq;
#pragma unroll
                        for (int bj = 0; bj < 2; ++bj) *(v4u*)(rp + bj * 32) = pack8(acc[ai][bj][m][0], acc[ai][bj][m][1]); } }
        } else if (pn == 6) {
            f32x4 g[2][2];
#pragma unroll
            for (int bj = 0; bj < 2; ++bj)
#pragma unroll
                for (int n = 0; n < 2; ++n) g[bj][n] = *(const f32x4*)(mqn + bj * 128 + cw + 4 * n);
#pragma unroll
            for (int ai = 0; ai < 2; ++ai)
#pragma unroll
                for (int m = 0; m < 4; ++m) { const int t = trow0 + ai * 128 + m * 16; float ss = 0.f;
#pragma unroll
                    for (int bj = 0; bj < 2; ++bj)
#pragma unroll
                        for (int n = 0; n < 2; ++n) { const f32x4 x = acc[ai][bj][m][n]; ss += (x[0] * x[0] + x[1] * x[1]) + (x[2] * x[2] + x[3] * x[3]); }
                    ss += swz_xor<16>(ss); ss = xor32_add(ss);
                    if (fq == 0) ssq_q[(size_t)t * 4 + wc] = ss;
#pragma unroll
                    for (int bj = 0; bj < 2; ++bj) *(v4u*)(cdq + (size_t)t * 256 + bj * 128 + cw) = pack8(acc[ai][bj][m][0] * g[bj][0], acc[ai][bj][m][1] * g[bj][1]); }
        } else {
            f32x4 g[2];
#pragma unroll
            for (int n = 0; n < 2; ++n) g[n] = *(const f32x4*)(mkvn + cw + 4 * n);
#pragma unroll
            for (int ai = 0; ai < 2; ++ai)
#pragma unroll
                for (int m = 0; m < 4; ++m) { const int t = trow0 + ai * 128 + m * 16; float ss = 0.f;
#pragma unroll
                    for (int n = 0; n < 2; ++n) { const f32x4 x = acc[ai][0][m][n]; ss += (x[0] * x[0] + x[1] * x[1]) + (x[2] * x[2] + x[3] * x[3]); }
                    ss += swz_xor<16>(ss); ss = xor32_add(ss);
                    if (fq == 0) ssq_kv[(size_t)t * 4 + wc] = ss;
                    *(v4u*)(cdkv + (size_t)t * 128 + cw) = pack8(acc[ai][0][m][0] * g[0], acc[ai][0][m][1] * g[1]);
                    if (wc == 0) { const int pos = t & (SEQ - 1), tb = ((fq < 2) ? (pos >> 6) : (pos & 63)) * 8 + 4 * (fq & 1);
                        const f32x4 c = *(const f32x4*)(cosc + tb), s = *(const f32x4*)(sinc + tb), x1 = acc[ai][1][m][0], x2 = acc[ai][1][m][1];
                        const f32x4 o1 = x1 * c - x2 * s, o2 = x2 * c + x1 * s; v2u w1, w2; w1.x = cvt_pk_bf16(o1[0], o1[1]); w1.y = cvt_pk_bf16(o1[2], o1[3]); w2.x = cvt_pk_bf16(o2[0], o2[1]); w2.y = cvt_pk_bf16(o2[2], o2[3]);
                        *(v2u*)(kpe + (size_t)t * 32 + 4 * fq) = w1; *(v2u*)(kpe + (size_t)t * 32 + 16 + 4 * fq) = w2; } }
        }
    }
};

struct SchedMla { const char *cdq, *cdkv, *wuq, *wukv; int G, c;
    __device__ __forceinline__ bool next(int i, GUnit& u) const {
        const int L = i * G + c; if (L >= 256) return false; const int pm = L >> 2, s = L & 3;
        u.gat = nullptr; u.gn = 0; u.carry = 0; u.pm = pm; u.pn = s & 1; u.x0 = pm * 256; u.x1 = 0; u.kind = s >> 1;
        if (s < 2) { u.A = cdq + (size_t)pm * 256 * 512; u.lda2 = 512; u.B = wuq + (size_t)(s & 1) * 256 * 512; u.ldb2 = 512; u.nt = 4; }
        else { u.A = cdkv + (size_t)pm * 256 * 256; u.lda2 = 256; u.B = wukv + (size_t)(s & 1) * 256 * 256; u.ldb2 = 256; u.nt = 2; }
        return true;
    }
};
struct EpiMla { const float *ssq_q, *ssq_kv, *cosc, *sinc; bf16 *cq, *ck, *cv;
    __device__ __forceinline__ void operator()(Acc& acc, const GUnit& u, int wr, int wc, int fr, int fq, LAS unsigned char*, int, int) const {
        const int trow0 = u.pm * 256 + wr * 64 + fr;
#pragma unroll
        for (int ai = 0; ai < 2; ++ai)
#pragma unroll
            for (int m = 0; m < 4; ++m) { const int t = trow0 + ai * 128 + m * 16;
                if (u.kind == 0) { const f32x4 q4 = *(const f32x4*)(ssq_q + (size_t)t * 4); const float r = rsqrtf(((q4[0] + q4[1]) + (q4[2] + q4[3])) * (1.f / 256.f) + 1e-6f) * C2_C;
                    if (u.pn == 0) {
#pragma unroll
                        for (int bj = 0; bj < 2; ++bj) { const int h = 2 * bj + (wc >> 1), d = 32 * (wc & 1) + 8 * fq; *(v4u*)(cq + (size_t)t * 384 + h * 96 + d) = pack8(acc[ai][bj][m][0] * r, acc[ai][bj][m][1] * r); }
                    } else { const int pos = t & (SEQ - 1), tb = ((fq < 2) ? (pos >> 6) : (pos & 63)) * 8 + 4 * (fq & 1);
                        const f32x4 c = *(const f32x4*)(cosc + tb), s = *(const f32x4*)(sinc + tb), x1 = acc[ai][0][m][0] * r, x2 = acc[ai][0][m][1] * r;
                        const f32x4 o1 = x1 * c - x2 * s, o2 = x2 * c + x1 * s; v2u w1, w2; w1.x = cvt_pk_bf16(o1[0], o1[1]); w1.y = cvt_pk_bf16(o1[2], o1[3]); w2.x = cvt_pk_bf16(o2[0], o2[1]); w2.y = cvt_pk_bf16(o2[2], o2[3]);
                        bf16* rp = cq + (size_t)t * 384 + wc * 96 + 64 + 4 * fq; *(v2u*)rp = w1; *(v2u*)(rp + 16) = w2; }
                } else { const f32x4 q4 = *(const f32x4*)(ssq_kv + (size_t)t * 4); const float r = rsqrtf(((q4[0] + q4[1]) + (q4[2] + q4[3])) * (1.f / 128.f) + 1e-6f);
#pragma unroll
                    for (int bj = 0; bj < 2; ++bj) { const int h = 2 * u.pn + bj; bf16* rp = ((wc < 2) ? ck : cv) + (size_t)t * 256 + h * 64 + 32 * (wc & 1) + 8 * fq; *(v4u*)rp = pack8(acc[ai][bj][m][0] * r, acc[ai][bj][m][1] * r); } }
            }
    }
};

struct SchedMerge { const char *ya, *yb, *yc, *wa, *wb, *wc; int G, c;
    __device__ __forceinline__ bool next(int i, GUnit& u) const {
        int pm, pn; if (!static_order(i / 3, G, c, 64, 4, pm, pn)) return false; const int s = i % 3;
        u.gat = nullptr; u.gn = 0; u.carry = (s != 0); u.pm = pm; u.pn = pn; u.x0 = pm * 256; u.x1 = 0; u.kind = s;
        if (s == 0) { u.A = ya + (size_t)pm * 256 * 512; u.lda2 = 512; u.B = wa + (size_t)pn * 256 * 512; u.ldb2 = 512; u.nt = 4; }
        else if (s == 1) { u.A = yb + (size_t)pm * 256 * 1024; u.lda2 = 1024; u.B = wb + (size_t)pn * 256 * 1024; u.ldb2 = 1024; u.nt = 8; }
        else { u.A = yc + (size_t)pm * 256 * 512; u.lda2 = 512; u.B = wc + (size_t)pn * 256 * 512; u.ldb2 = 512; u.nt = 4; }
        return true;
    }
};
struct EpiMerge { const bf16* gates; bf16* merged;
    __device__ __forceinline__ void operator()(Acc& acc, const GUnit& u, int wr, int wc, int fr, int fq, LAS unsigned char*, int, int) const {
        const int trow0 = u.pm * 256 + wr * 64 + fr, col0 = u.pn * 256 + wc * 32 + 8 * fq, s = u.kind;
#pragma unroll
        for (int ai = 0; ai < 2; ++ai)
#pragma unroll
            for (int m = 0; m < 4; ++m) { const int t = trow0 + ai * 128 + m * 16; const bf16* gp = gates + (size_t)t * 3072 + col0;
#pragma unroll
                for (int bj = 0; bj < 2; ++bj) { const v4u ga = *(const v4u*)(gp + s * 1024 + bj * 128); f32x4 f0 = unpack_lo(ga), f1 = unpack_hi(ga);
                    if (s < 2) { const v4u gb = *(const v4u*)(gp + (s + 1) * 1024 + bj * 128); const f32x4 d0 = unpack_lo(gb), d1 = unpack_hi(gb);
#pragma unroll
                        for (int e = 0; e < 4; ++e) { f0[e] *= __builtin_amdgcn_rcpf(fmaxf(d0[e], 1e-30f)); f1[e] *= __builtin_amdgcn_rcpf(fmaxf(d1[e], 1e-30f)); } }
                    acc[ai][bj][m][0] *= f0; acc[ai][bj][m][1] *= f1;
                    if (s == 2) *(v4u*)(merged + (size_t)t * 1024 + col0 + bj * 128) = pack8(acc[ai][bj][m][0], acc[ai][bj][m][1]); } }
    }
};

struct SchedXS { const char *xq, *memk; int G, c;
    __device__ __forceinline__ bool next(int i, GUnit& u) const {
        const int L = i * G + c; if (L >= 256) return false; const int pm = L >> 2, h = L & 3, b = pm >> 4;
        u.A = xq + (size_t)pm * 256 * 2048 + h * 512; u.lda2 = 2048; u.B = memk + (size_t)b * 256 * 2048 + h * 512; u.ldb2 = 2048; u.nt = 4; u.gat = nullptr; u.gn = 0; u.carry = 0; u.kind = 0; u.pm = pm; u.pn = 0; u.x0 = pm * 256; u.x1 = h * 256; return true;
    }
};
struct SchedXO { const char *px, *memvt; int G, c;
    __device__ __forceinline__ bool next(int i, GUnit& u) const {
        const int L = i * G + c; if (L >= 256) return false; const int pm = L >> 2, h = L & 3, b = pm >> 4;
        u.A = px + (size_t)pm * 256 * 2048 + h * 512; u.lda2 = 2048; u.B = memvt + (size_t)h * 256 * 2048 + b * 512; u.ldb2 = 2048; u.nt = 4; u.gat = nullptr; u.gn = 0; u.carry = 0; u.kind = 0; u.pm = pm; u.pn = 0; u.x0 = pm * 256; u.x1 = h * 256; return true;
    }
};
struct EpiXS { bf16* px;
    __device__ __forceinline__ void operator()(Acc& acc, const GUnit& u, int wr, int wc, int fr, int fq, LAS unsigned char* lds, int, int) const {
        LAS float* red = (LAS float*)lds; LAS float* red2 = red + 1024;
        float mx[2][4];
#pragma unroll
        for (int ai = 0; ai < 2; ++ai)
#pragma unroll
            for (int m = 0; m < 4; ++m) { float v = -INFINITY;
#pragma unroll
                for (int bj = 0; bj < 2; ++bj)
#pragma unroll
                    for (int n = 0; n < 2; ++n) { const f32x4 x = acc[ai][bj][m][n]; v = fmaxf(v, fmaxf(fmaxf(x[0], x[1]), fmaxf(x[2], x[3]))); }
                v = fmaxf(v, swz_xor<16>(v)); v = xor32_max(v); mx[ai][m] = v;
                if (fq == 0) red[(ai * 128 + wr * 64 + m * 16 + fr) * 4 + wc] = v; }
        asm volatile("s_waitcnt lgkmcnt(0)" ::: "memory"); __builtin_amdgcn_s_barrier(); asm volatile("" ::: "memory");
        float sm[2][4];
#pragma unroll
        for (int ai = 0; ai < 2; ++ai)
#pragma unroll
            for (int m = 0; m < 4; ++m) { const f32x4 q = *(const LAS f32x4*)(red + (ai * 128 + wr * 64 + m * 16 + fr) * 4); const float mt = fmaxf(fmaxf(q[0], q[1]), fmaxf(q[2], q[3])); float s = 0.f;
#pragma unroll
                for (int bj = 0; bj < 2; ++bj)
#pragma unroll
                    for (int n = 0; n < 2; ++n)
#pragma unroll
                        for (int e = 0; e < 4; ++e) { const float p = __builtin_amdgcn_exp2f(acc[ai][bj][m][n][e] - mt); acc[ai][bj][m][n][e] = p; s += p; }
                s += swz_xor<16>(s); s = xor32_add(s); sm[ai][m] = s;
                if (fq == 0) red2[(ai * 128 + wr * 64 + m * 16 + fr) * 4 + wc] = s; }
        asm volatile("s_waitcnt lgkmcnt(0)" ::: "memory"); __builtin_amdgcn_s_barrier(); asm volatile("" ::: "memory");
        const int row0 = u.x0 + wr * 64 + fr, col0 = u.x1 + wc * 32 + 8 * fq;
#pragma unroll
        for (int ai = 0; ai < 2; ++ai)
#pragma unroll
            for (int m = 0; m < 4; ++m) { const f32x4 q = *(const LAS f32x4*)(red2 + (ai * 128 + wr * 64 + m * 16 + fr) * 4); const float il = __builtin_amdgcn_rcpf((q[0] + q[1]) + (q[2] + q[3]));
                bf16* rp = px + (size_t)(row0 + ai * 128 + m * 16) * 1024 + col0;
#pragma unroll
                for (int bj = 0; bj < 2; ++bj) *(v4u*)(rp + bj * 128) = pack8(acc[ai][bj][m][0] * il, acc[ai][bj][m][1] * il); }
        (void)mx; (void)sm;
    }
};

struct SchedMoe { const char* A; const char* W; size_t wstride; unsigned lda2, ldb2; int nt, nN; const int* list; const int* segbase; const int* segcnt; int G, c; bool gather;
    __device__ __forceinline__ bool next(int i, GUnit& u) const {
        const int L = i * G + c; const int nrt = uload_i(segbase + NE) >> 8; if (L >= nrt * nN) return false;
        const int rt = L / nN, pn = L % nN, row0 = rt * 256; int e = 0, sbe = 0;
#pragma unroll
        for (int k = 1; k < NE; ++k) { const int sk = uload_i(segbase + k); if (row0 >= sk) { e = k; sbe = sk; } }
        u.B = W + (size_t)e * wstride + (size_t)pn * 256 * ldb2; u.ldb2 = ldb2; u.lda2 = lda2; u.nt = nt; u.carry = 0; u.kind = 0; u.pm = rt; u.pn = pn; u.x0 = row0; u.x1 = 0;
        if (gather) { u.A = A; u.gat = list + row0; int gn = sbe + uload_i(segcnt + e) - row0; u.gn = gn > 256 ? 256 : gn; }
        else { u.A = A + (size_t)row0 * lda2; u.gat = nullptr; u.gn = 0; }
        return true;
    }
};
}

namespace fa {
constexpr int A_SLOT = 20480, A_NSL = 3, A_WS = A_NSL * A_SLOT  , A_OST = A_WS + 2048, A_END = A_OST + NWAVES * 4096;
static_assert(A_END <= RING_BYTES, "attention LDS map");
constexpr float THR = 8.f;
__device__ __forceinline__ int crow(int r, int hi) { return (r & 3) + 8 * (r >> 2) + 4 * hi; }
__device__ __forceinline__ void glds16(const void* gsrc, unsigned lds_dst) { unsigned keep;
    asm volatile("s_mov_b32 %0, m0\n\ts_mov_b32 m0, %2\n\ts_nop 0\n\tglobal_load_lds_dwordx4 %1, off\n\ts_mov_b32 m0, %0" : "=&s"(keep) : "v"(gsrc), "s"(lds_dst) : "memory"); }
typedef short v4i16_t __attribute__((ext_vector_type(4)));
__device__ __forceinline__ s16x4 vtr(const LAS char* p) { return __builtin_bit_cast(s16x4, __builtin_amdgcn_ds_read_tr16_b64_v4i16((LAS v4i16_t*)p)); }
__device__ __forceinline__ unsigned cvtpk_s(float lo, float hi) { typedef __bf16 bf16x2_t __attribute__((ext_vector_type(2))); f32x2 v = {lo, hi}; bf16x2_t b = __builtin_convertvector(v, bf16x2_t); return __builtin_bit_cast(unsigned, b); }
#define FA_WAIT_BAR(N) asm volatile("s_waitcnt vmcnt(" #N ") lgkmcnt(0)\n\ts_barrier" ::: "memory")

struct AttnArgs {
    const bf16* Qw; int pitchQ;
    const bf16* K1; int pitchK1;
    const bf16* K2; int pitchK2;
    const bf16* V; int pitchV;
    bf16* Ow; int pitchO;
    int NT;
    int t_lo, t_hi;
    int dr0;
    int cq0;
    const LAS float* rpbs;
};

template <int DK1, int DK2, int DV, bool NA>
__device__ __forceinline__ void attn_unit(LAS unsigned char* shm, const AttnArgs& a, int wave_) {
    constexpr int DK = DK1 + DK2, NKC = DK / 8, ND0 = DK / 16, NG = DV / 32, KB = 64 * DK * 2;
    static_assert(KB + 64 * DV * 2 <= A_SLOT && DV == 64, "slot size / DV");
    int tid_ = wave_ * 64 + lane_id_opaque(); asm volatile("" : "+v"(tid_));
    const int tid = tid_, lane = tid & 63, r32 = lane & 31, hi = lane >> 5; const int wid = __builtin_amdgcn_readfirstlane(tid >> 6);
    const unsigned lds0 = (unsigned)(size_t)shm;
    LAS float* wsf = (LAS float*)(shm + A_WS) + wid * 64;
    bf16x8 qr[ND0];
#pragma unroll
    for (int d0 = 0; d0 < ND0; ++d0) qr[d0] = *(const bf16x8*)(a.Qw + (size_t)r32 * a.pitchQ + d0 * 16 + hi * 8);
#define FA_DMA(t_, s_) do { const unsigned sb_ = lds0 + (unsigned)(s_) * A_SLOT; \
        _Pragma("unroll") for (int cc_ = 0; cc_ < 2; ++cc_) { const int c_ = wid + 8 * cc_; if (c_ < NKC) { \
            const bf16* src_ = (c_ < DK1 / 8) ? (a.K1 + (size_t)(64 * (t_) + lane) * a.pitchK1 + c_ * 8) : (a.K2 + (size_t)(64 * (t_) + lane) * a.pitchK2 + (c_ - DK1 / 8) * 8); \
            glds16(src_, (unsigned)__builtin_amdgcn_readfirstlane(sb_ + c_ * 1024)); } } \
        { const int g_ = wid >> 2, ks_ = wid & 3; const bf16* src_ = a.V + (size_t)(64 * (t_) + 16 * ks_ + (lane >> 2)) * a.pitchV + g_ * 32 + (lane & 3) * 8; \
          glds16(src_, (unsigned)__builtin_amdgcn_readfirstlane(sb_ + KB + g_ * 4096 + ks_ * 1024)); } } while (0)
    FA_DMA(0, 0); if (a.NT > 1) FA_DMA(1, 1);
    float mhat = 0.f, l_reg = 0.f; f32x16 o[NG];
#pragma unroll
    for (int g = 0; g < NG; ++g) o[g] = f32x16{};
    f32x16 negm = f32x16{};
    bool started = false;
    int s_cur = 0;
    for (int t = 0; t < a.NT; ++t) {
        if (t + 1 < a.NT) { FA_WAIT_BAR(2); } else { FA_WAIT_BAR(0); }
        if (t + 2 < a.NT) FA_DMA(t + 2, (s_cur + 2) % 3);
        if (!NA || (t >= a.t_lo && t < a.t_hi)) {
            const LAS unsigned char* Ks = shm + s_cur * A_SLOT; const LAS unsigned char* kb = Ks + hi * 1024 + r32 * 16;
            f32x16 p0 = negm, p1 = negm;
#pragma unroll
            for (int d0 = 0; d0 < ND0; ++d0) { const bf16x8 b0 = *(const LAS bf16x8*)(kb + d0 * 2048), b1 = *(const LAS bf16x8*)(kb + d0 * 2048 + 512);
                p0 = __builtin_amdgcn_mfma_f32_32x32x16_bf16(b0, qr[d0], p0, 0, 0, 0); p1 = __builtin_amdgcn_mfma_f32_32x32x16_bf16(b1, qr[d0], p1, 0, 0, 0); }
            if constexpr (NA) { const int c = a.cq0 + r32; int cs = c - 8; cs = cs < 0 ? 0 : (cs > 48 ? 48 : cs); const LAS float* brow = a.rpbs + (a.dr0 + t) * 32;
#pragma unroll
                for (int r = 0; r < 16; ++r) { const int kc = crow(r, hi); const int dc0 = kc - c + 15, dc1 = dc0 + 32;
                    const float b0 = brow[dc0 & 31], b1 = brow[dc1 & 31];
                    p0[r] = ((unsigned)(kc - cs) < 16u) ? p0[r] + b0 : -INFINITY; p1[r] = ((unsigned)(kc + 32 - cs) < 16u) ? p1[r] + b1 : -INFINITY; } }
            float rm = fmaxf(p0[0], p1[0]);
#pragma unroll
            for (int r = 1; r < 16; ++r) rm = fmaxf(rm, fmaxf(p0[r], p1[r]));
            rm = xor32_max(rm);
            bool resc = false;
            if (!started) { const float dl = rm; mhat = dl;
#pragma unroll
                for (int r = 0; r < 16; ++r) { p0[r] -= dl; p1[r] -= dl; }
#pragma unroll
                for (int r = 0; r < 16; ++r) negm[r] = -mhat;
                started = true;
            } else if (__any(rm > THR)) { const float dl = fmaxf(rm, 0.f); mhat += dl;
#pragma unroll
                for (int r = 0; r < 16; ++r) { p0[r] -= dl; p1[r] -= dl; }
#pragma unroll
                for (int r = 0; r < 16; ++r) negm[r] = -mhat;
                const float f = __builtin_amdgcn_exp2f(-dl); l_reg *= f; if (hi == 0) wsf[r32] = f; resc = true; }
            float sacc = 0.f;
#pragma unroll
            for (int r = 0; r < 16; ++r) { p0[r] = __builtin_amdgcn_exp2f(p0[r]); p1[r] = __builtin_amdgcn_exp2f(p1[r]); sacc += p0[r] + p1[r]; }
            l_reg += sacc;
            if (resc) { asm volatile("s_waitcnt lgkmcnt(0)" ::: "memory");
#pragma unroll
                for (int g = 0; g < NG; ++g)
#pragma unroll
                    for (int r = 0; r < 16; ++r) o[g][r] *= wsf[crow(r, hi)]; }
            bf16x8 pa[4];
#pragma unroll
            for (int s = 0; s < 4; ++s) { const int b = 8 * (s & 1); v4u w;
                if (s < 2) { w.x = cvtpk_s(p0[b], p0[b + 1]); w.y = cvtpk_s(p0[b + 2], p0[b + 3]); w.z = cvtpk_s(p0[b + 4], p0[b + 5]); w.w = cvtpk_s(p0[b + 6], p0[b + 7]); }
                else { w.x = cvtpk_s(p1[b], p1[b + 1]); w.y = cvtpk_s(p1[b + 2], p1[b + 3]); w.z = cvtpk_s(p1[b + 4], p1[b + 5]); w.w = cvtpk_s(p1[b + 6], p1[b + 7]); }
                pa[s] = __builtin_bit_cast(bf16x8, w); }
            const LAS char* vp = (const LAS char*)(Ks + KB) + ((lane >> 4) & 1) * 32 + (lane & 3) * 8 + (4 * hi + ((lane & 15) >> 2)) * 64;
#pragma unroll
            for (int g = 0; g < NG; ++g)
#pragma unroll
                for (int s = 0; s < 4; ++s) { const s16x4 lo = vtr(vp + g * 4096 + s * 1024), hh = vtr(vp + g * 4096 + s * 1024 + 512);
                    const bf16x8 vf = (bf16x8){lo[0], lo[1], lo[2], lo[3], hh[0], hh[1], hh[2], hh[3]};
                    o[g] = __builtin_amdgcn_mfma_f32_32x32x16_bf16(pa[s], vf, o[g], 0, 0, 0); }
        }
        s_cur = (s_cur + 1) % 3;
    }
    l_reg = xor32_add(l_reg);
    if (hi == 0) wsf[32 + r32] = l_reg; asm volatile("s_waitcnt lgkmcnt(0)" ::: "memory");
    LAS bf16* stg = (LAS bf16*)(shm + A_OST) + wid * 2048;
#pragma unroll
    for (int r = 0; r < 16; ++r) { const int orow = crow(r, hi); const float rl = __builtin_amdgcn_rcpf(wsf[32 + orow]);
#pragma unroll
        for (int g = 0; g < NG; ++g) stg[orow * 64 + g * 32 + r32] = (bf16)f2bf(o[g][r] * rl); }
    asm volatile("s_waitcnt lgkmcnt(0)" ::: "memory");
#pragma unroll
    for (int i = 0; i < 4; ++i) { const int row = i * 8 + (lane >> 3), ch = lane & 7; const v4u v = *(const LAS v4u*)(stg + row * 64 + ch * 8); *(v4u*)(a.Ow + (size_t)row * a.pitchO + ch * 8) = v; }
    asm volatile("s_waitcnt vmcnt(0) lgkmcnt(0)\n\ts_barrier" ::: "memory");
}
}

constexpr size_t O_WIN = 0, O_WUQ = 5242880, O_WUKV = 5373952, O_WPA = 5439488, O_WPB = 5701632, O_WPC = 6225920, O_WOUT = 6488064, O_WQ = 7536640, O_WKV = 8585216, O_WO = 10682368, LSTRIDE = 11730944;
constexpr size_t O_GU = 0, O_DOWN = 5767168, FSTRIDE = 8650752;
constexpr size_t W_FFN = 4 * LSTRIDE, W_MOE = W_FFN + 2 * FSTRIDE, W_TOTAL = W_MOE + 16 * FSTRIDE;
static_assert(WS_WEIGHTS + W_TOTAL * 2 <= WS_END, "weights fit");

struct FP { const float* in[26]; float* out; unsigned char* ws; int l; int pad; };
typedef const __attribute__((address_space(4))) FP* KP;
__device__ __forceinline__ KP kargs() { const unsigned long long v = (unsigned long long)__builtin_amdgcn_kernarg_segment_ptr(); unsigned lo = (unsigned)v, hi = (unsigned)(v >> 32); asm volatile("" : "+s"(lo), "+s"(hi)); return (KP)(((unsigned long long)hi << 32) | lo); }
struct Ctx {
    LAS unsigned char* lds; int wave, vcu, G, bx; unsigned char* ws; KP p;
    __device__ __forceinline__ bf16* W(size_t off) const { return (bf16*)(ws + WS_WEIGHTS) + off; }
    template <class Tp> __device__ __forceinline__ Tp* at(size_t off) const { return (Tp*)(ws + off); }
};
__device__ __forceinline__ int otid(int wave) { int t = wave * 64 + lane_id_opaque(); asm volatile("" : "+v"(t)); return t; }
__device__ __forceinline__ Ctx fresh(const Ctx& c) { Ctx r = c; r.p = kargs(); r.ws = r.p->ws; asm volatile("" : "+s"(r.wave), "+s"(r.vcu), "+s"(r.G), "+s"(r.bx)); return r; }
__device__ __forceinline__ float wave_sum_f(float v) { v += swz_xor<1>(v); v += swz_xor<2>(v); v += swz_xor<4>(v); v += swz_xor<8>(v); v += swz_xor<16>(v); return xor32_add(v); }

__device__ __forceinline__ int pe_perm(int w) { return 16 * ((w >> 2) & 1) + 4 * (w >> 3) + (w & 3); }
__device__ __forceinline__ void conv_item(const float* W, int K, int Nsrc, bf16* WT, int grp, int kb, int lb, bool perm, LAS float* scr, int lane) {
    const int k0 = 64 * kb, c = lane & 7;
    if (lb < 0) {
#pragma unroll
        for (int j = 0; j < 4; ++j) { const int n = (lane >> 3) + 8 * j; *(GAS v4u*)(WT + (size_t)(grp * 32 + n) * K + k0 + 8 * c) = (v4u){0u, 0u, 0u, 0u}; }
        return; }
#pragma unroll 16
    for (int i = 0; i < 32; ++i) { const int kk = 2 * i + (lane >> 5); scr[kk * 33 + (lane & 31)] = W[(size_t)(k0 + kk) * Nsrc + lb + (lane & 31)]; }
    LDS_WAIT(); asm volatile("" ::: "memory");
#pragma unroll
    for (int j = 0; j < 4; ++j) { const int n = (lane >> 3) + 8 * j; const int ns = perm ? pe_perm(n) : n; const LAS float* s = scr + (8 * c) * 33 + ns;
        v4u o; o.x = f2bf(s[0 * 33]) | (f2bf(s[1 * 33]) << 16); o.y = f2bf(s[2 * 33]) | (f2bf(s[3 * 33]) << 16); o.z = f2bf(s[4 * 33]) | (f2bf(s[5 * 33]) << 16); o.w = f2bf(s[6 * 33]) | (f2bf(s[7 * 33]) << 16);
        *(GAS v4u*)(WT + (size_t)(grp * 32 + n) * K + k0 + 8 * c) = o; }
    LDS_WAIT(); asm volatile("" ::: "memory");
}
__device__ __forceinline__ int gmap_in(int G, bool& perm) { const int pn = G >> 3, g8 = G & 7, bj = g8 >> 2, wc = g8 & 3; perm = false;
    if (pn <= 2) return pn * 256 + g8 * 32;
    if (pn <= 4) return 768 + (pn - 3) * 256 + wc * 64 + bj * 32;
    if (pn == 5) return (wc < 2) ? (1280 + wc * 64 + bj * 32) : (1408 + (wc - 2) * 64 + bj * 32);
    if (pn == 6) return 1536 + g8 * 32;
    if (pn == 7) { if (g8 < 4) return 1792 + g8 * 32; if (g8 == 4) { perm = true; return 1920; } return -1; }
    return 1952 + (pn - 8) * 256 + g8 * 32; }
__device__ __forceinline__ int gmap_uq(int G, bool& perm) { perm = false; if (G < 8) return 96 * (G >> 1) + 32 * (G & 1); if (G < 12) { perm = true; return 96 * (G - 8) + 64; } return -1; }
__device__ __forceinline__ int gmap_gu(int G) { const int pn = G >> 3, g8 = G & 7; return ((g8 >> 2) ? DFF : 0) + 128 * pn + 32 * (g8 & 3); }

constexpr int NJOB = 14;
__device__ __forceinline__ void ph_convert(const Ctx& c) {
    const KP p_ = c.p;
    LAS float* scr = (LAS float*)(c.lds + c.wave * 16384);
    const int tid_ = otid(c.wave), lane_ = tid_ & 63;
    const int gw = c.vcu * NWAVES + c.wave, NGW = c.G * NWAVES;
    constexpr int J_REPS[NJOB] = {4, 4, 4, 4, 4, 4, 4, 4, 4, 4, 2, 2, 16, 16};
    constexpr int J_K[NJOB] = {1024, 256, 128, 256, 512, 256, 1024, 1024, 1024, 1024, 1024, 2816, 1024, 2816};
    constexpr int J_NS[NJOB] = {5024, 384, 512, 1024, 1024, 1024, 1024, 1024, 2048, 1024, 5632, 1024, 5632, 1024};
    constexpr int J_NG[NJOB] = {160, 16, 16, 32, 32, 32, 32, 32, 64, 32, 176, 32, 176, 32};
    constexpr int J_IN[NJOB] = {4, 10, 11, 12, 13, 14, 15, 16, 17, 18, 21, 22, 24, 25};
    int total = 0;
#pragma unroll
    for (int j = 0; j < NJOB; ++j) total += J_REPS[j] * J_NG[j] * (J_K[j] / 64);
    for (int it = gw; it < total; it += NGW) {
        int r = it, job = 0, K = 0, NS = 0, NGp = 0, rep = 0; bool found = false;
#pragma unroll
        for (int j = 0; j < NJOB; ++j) { const int per = J_NG[j] * (J_K[j] / 64), cnt = J_REPS[j] * per;
            if (!found) { if (r < cnt) { found = true; job = j; K = J_K[j]; NS = J_NS[j]; NGp = J_NG[j]; rep = r / per; r = r % per; } else r -= cnt; } }
        const int kb = r / NGp, grp = r % NGp;
        const float* src = p_->in[J_IN[0]]; bf16* dst = c.W(0); int lb = grp * 32; bool perm = false;
        switch (job) {
            case 0: src = p_->in[4] + (size_t)rep * D * INC; dst = c.W(rep * LSTRIDE + O_WIN); lb = gmap_in(grp, perm); break;
            case 1: src = p_->in[10] + (size_t)rep * 256 * 384; dst = c.W(rep * LSTRIDE + O_WUQ); lb = gmap_uq(grp, perm); break;
            case 2: src = p_->in[11] + (size_t)rep * 128 * 512; dst = c.W(rep * LSTRIDE + O_WUKV); break;
            case 3: src = p_->in[12] + (size_t)rep * 256 * D; dst = c.W(rep * LSTRIDE + O_WPA); break;
            case 4: src = p_->in[13] + (size_t)rep * 512 * D; dst = c.W(rep * LSTRIDE + O_WPB); break;
            case 5: src = p_->in[14] + (size_t)rep * 256 * D; dst = c.W(rep * LSTRIDE + O_WPC); break;
            case 6: src = p_->in[15] + (size_t)rep * D * D; dst = c.W(rep * LSTRIDE + O_WOUT); break;
            case 7: src = p_->in[16] + (size_t)rep * D * D; dst = c.W(rep * LSTRIDE + O_WQ); break;
            case 8: src = p_->in[17] + (size_t)rep * D * 2 * D; dst = c.W(rep * LSTRIDE + O_WKV); break;
            case 9: src = p_->in[18] + (size_t)rep * D * D; dst = c.W(rep * LSTRIDE + O_WO); break;
            case 10: src = p_->in[21] + (size_t)rep * D * 2 * DFF; dst = c.W(W_FFN + rep * FSTRIDE + O_GU); lb = gmap_gu(grp); break;
            case 11: src = p_->in[22] + (size_t)rep * DFF * D; dst = c.W(W_FFN + rep * FSTRIDE + O_DOWN); break;
            case 12: src = p_->in[24] + (size_t)rep * D * 2 * DFF; dst = c.W(W_MOE + rep * FSTRIDE + O_GU); lb = gmap_gu(grp); break;
            default: src = p_->in[25] + (size_t)rep * DFF * D; dst = c.W(W_MOE + rep * FSTRIDE + O_DOWN); break;
        }
        conv_item(src, K, NS, dst, grp, kb, lb, perm, scr, lane_);
    }
    { const int i = c.bx * 512 + tid_; float* cosb = c.at<float>(WS_TAB); float* sinb = cosb + 1024; float* cosc = cosb + 2048; float* sinc = cosb + 2560;
      if (i < 64 * 16) { const int v = i / 16, j = i % 16; const float f = powf(10000.0f, -(float)j / 16.0f); const float a = (float)v * f; cosb[i] = cosf(a); sinb[i] = sinf(a); }
      if (i < 64 * 8) { const int v = i / 8, j = i % 8; const float f = powf(10000.0f, -(float)j / 8.0f); const float a = (float)v * f; cosc[i] = cosf(a); sinc[i] = sinf(a); } }
    { bf16* memb = c.at<bf16>(WS_MEMB); const float* mem = p_->in[1];
      for (int i = (c.bx * 512 + tid_) * 4; i < 1024 * 1024; i += c.G * 512 * 4) { const f32x4 v = *(const f32x4*)(mem + i); v2u w; w.x = f2bf(v[0]) | (f2bf(v[1]) << 16); w.y = f2bf(v[2]) | (f2bf(v[3]) << 16); *(v2u*)(memb + i) = w; } }
}

__device__ __forceinline__ void ph_ln(const Ctx& c, int mode, const float* g, const float* b, bool route, const float* wr, bool last) {
    const KP p_ = c.p; float* hf = c.at<float>(WS_HF); bf16* hb = c.at<bf16>(WS_HB); const float* pre = c.at<float>(WS_F); const float* y = c.at<float>(WS_Y);
    const int* tslot = c.at<int>(WS_ROUTE + 256 * 1024); const float* rw = c.at<float>(WS_ROUTE + 128 * 1024); int* re = c.at<int>(WS_ROUTE); float* rwo = c.at<float>(WS_ROUTE + 128 * 1024);
    const int gw = c.vcu * NWAVES + c.wave, NGW = c.G * NWAVES, lane = otid(c.wave) & 63;
    f32x4 gg[4], bb[4];
#pragma unroll
    for (int j = 0; j < 4; ++j) { gg[j] = *(const f32x4*)(g + 4 * lane + 256 * j); bb[j] = *(const f32x4*)(b + 4 * lane + 256 * j); }
    for (int row = gw; row < T; row += NGW) {
        f32x4 v[4]; float s = 0.f; const size_t ro = (size_t)row * D + 4 * lane;
        if (mode == 0) {
#pragma unroll
            for (int j = 0; j < 4; ++j) v[j] = *(const f32x4*)(p_->in[0] + ro + 256 * j);
        } else if (mode == 1) {
#pragma unroll
            for (int j = 0; j < 4; ++j) v[j] = *(const f32x4*)(hf + ro + 256 * j) * ALPHA + *(const f32x4*)(pre + ro + 256 * j);
        } else { const int s0 = uload_i(tslot + row * 2), s1 = uload_i(tslot + row * 2 + 1); const float w0 = uload_f(rw + row * 2), w1 = uload_f(rw + row * 2 + 1);
#pragma unroll
            for (int j = 0; j < 4; ++j) v[j] = *(const f32x4*)(hf + ro + 256 * j) * ALPHA + (*(const f32x4*)(y + (size_t)s0 * D + 4 * lane + 256 * j) * w0 + *(const f32x4*)(y + (size_t)s1 * D + 4 * lane + 256 * j) * w1);
        }
#pragma unroll
        for (int j = 0; j < 4; ++j) s += (v[j][0] + v[j][1]) + (v[j][2] + v[j][3]);
        const float mean = wave_sum_f(s) * (1.f / D); float q = 0.f;
#pragma unroll
        for (int j = 0; j < 4; ++j) { v[j] = v[j] - mean; q += (v[j][0] * v[j][0] + v[j][1] * v[j][1]) + (v[j][2] * v[j][2] + v[j][3] * v[j][3]); }
        const float rstd = rsqrtf(wave_sum_f(q) * (1.f / D) + 1e-5f);
#pragma unroll
        for (int j = 0; j < 4; ++j) { v[j] = v[j] * rstd * gg[j] + bb[j]; *(f32x4*)(hf + ro + 256 * j) = v[j]; if (last) *(f32x4*)(p_->out + ro + 256 * j) = v[j];
            v2u w; w.x = fg::cvt_pk_bf16(v[j][0], v[j][1]); w.y = fg::cvt_pk_bf16(v[j][2], v[j][3]); *(v2u*)(hb + ro + 256 * j) = w; }
        if (route) { float acc[NE];
#pragma unroll
            for (int e = 0; e < NE; ++e) acc[e] = 0.f;
#pragma unroll
            for (int j = 0; j < 4; ++j)
#pragma unroll
                for (int i = 0; i < 4; ++i) { const float* wp = wr + (size_t)(4 * lane + 256 * j + i) * NE; const f32x4 w0 = *(const f32x4*)wp, w1 = *(const f32x4*)(wp + 4); const float x = v[j][i];
                    acc[0] += x * w0[0]; acc[1] += x * w0[1]; acc[2] += x * w0[2]; acc[3] += x * w0[3]; acc[4] += x * w1[0]; acc[5] += x * w1[1]; acc[6] += x * w1[2]; acc[7] += x * w1[3]; }
#pragma unroll
            for (int e = 0; e < NE; ++e) acc[e] = wave_sum_f(acc[e]);
            if (lane == 0) { int e0 = 0; float l0 = acc[0];
#pragma unroll
                for (int e = 1; e < NE; ++e) if (acc[e] > l0) { l0 = acc[e]; e0 = e; }
                int e1 = -1; float l1 = -INFINITY;
#pragma unroll
                for (int e = 0; e < NE; ++e) if (e != e0 && acc[e] > l1) { l1 = acc[e]; e1 = e; }
                const float p1 = expf(l1 - l0), w0 = 1.f / (1.f + p1), w1 = p1 / (1.f + p1);
                re[row * 2] = e0; re[row * 2 + 1] = e1; rwo[row * 2] = w0; rwo[row * 2 + 1] = w1; } }
    }
}
__device__ __forceinline__ void ph_moe_count(const Ctx& c) {
    const int* re = c.at<int>(WS_ROUTE); int* cnt = c.at<int>(WS_ROUTE + 640 * 1024); const int gw = c.vcu * NWAVES + c.wave, NGW = c.G * NWAVES, lane = otid(c.wave) & 63;
    for (int blk = gw; blk < T / 64; blk += NGW) { const int t = blk * 64 + lane; const int e0 = re[t * 2], e1 = re[t * 2 + 1];
#pragma unroll
        for (int e = 0; e < NE; ++e) { const unsigned long long mk = __ballot(e0 == e || e1 == e); if (lane == 0) cnt[blk * NE + e] = __popcll(mk); } }
}
__device__ __forceinline__ void ph_moe_assign(const Ctx& c) {
    const int* re = c.at<int>(WS_ROUTE); const int* cnt = c.at<int>(WS_ROUTE + 640 * 1024); int* tslot = c.at<int>(WS_ROUTE + 256 * 1024); int* list = c.at<int>(WS_ROUTE + 384 * 1024);
    int* segbase = c.at<int>(WS_ROUTE + 704 * 1024); int* segcnt = c.at<int>(WS_ROUTE + 705 * 1024);
    const int gw = c.vcu * NWAVES + c.wave, NGW = c.G * NWAVES, lane = otid(c.wave) & 63;
    for (int blk = gw; blk < T / 64; blk += NGW) { const int t = blk * 64 + lane; const int e0 = re[t * 2], e1 = re[t * 2 + 1]; int base = 0;
#pragma unroll
        for (int e = 0; e < NE; ++e) { int s = 0, sb = 0;
#pragma unroll
            for (int k = 0; k < 4; ++k) { const int b2 = lane + 64 * k; const int cc = cnt[b2 * NE + e]; s += cc; if (b2 < blk) sb += cc; }
            s += swz_xor_i<1>(s); s += swz_xor_i<2>(s); s += swz_xor_i<4>(s); s += swz_xor_i<8>(s); s += swz_xor_i<16>(s); s = xor32_add_i(s);
            sb += swz_xor_i<1>(sb); sb += swz_xor_i<2>(sb); sb += swz_xor_i<4>(sb); sb += swz_xor_i<8>(sb); sb += swz_xor_i<16>(sb); sb = xor32_add_i(sb);
            if (blk == 0 && lane == 0) { segbase[e] = base; segcnt[e] = s; }
            const unsigned long long mk = __ballot(e0 == e || e1 == e); const int rank = __popcll(mk & ((1ull << lane) - 1ull));
            if (e0 == e || e1 == e) { const int slot = base + sb + rank; list[slot] = t; tslot[t * 2 + (e1 == e ? 1 : 0)] = slot; }
            base += (s + 255) & ~255; }
        if (blk == 0 && lane == 0) segbase[NE] = base; }
}

__device__ __forceinline__ void ph_memkv(const Ctx& c) {
    struct Sch { const char* memb; const char* w; bf16* memk; bf16* memvt; int G, c;
        __device__ __forceinline__ bool next(int i, fg::GUnit& u) const { const int L = i * G + c; if (L >= 128) return false; const int l = L >> 5, v = (L >> 4) & 1, pm = (L >> 2) & 3, pn = L & 3;
            const char* wl = w + (size_t)l * LSTRIDE * 2 + O_WKV * 2; u.lda2 = 2048; u.ldb2 = 2048; u.nt = 16; u.gat = nullptr; u.gn = 0; u.carry = 0; u.kind = l * 2 + v; u.pm = pm; u.pn = pn; u.x0 = pm * 256; u.x1 = 0;
            if (!v) { u.A = memb + (size_t)pm * 256 * 2048; u.B = wl + (size_t)pn * 256 * 2048; } else { u.A = wl + (size_t)(1024 + pm * 256) * 2048; u.B = memb + (size_t)pn * 256 * 2048; } return true; } };
    struct Ep { bf16* memk; bf16* memvt;
        __device__ __forceinline__ void operator()(fg::Acc& acc, const fg::GUnit& u, int wr, int wc, int fr, int fq, LAS unsigned char*, int, int) const {
            bf16* C = memk + (size_t)(u.kind & 1) * ((WS_MEMVT - WS_MEMK) / 2) + (size_t)(u.kind >> 1) * 1024 * 1024; const int row0 = u.x0 + wr * 64 + fr, col0 = u.pn * 256 + wc * 32 + 8 * fq;
#pragma unroll
            for (int ai = 0; ai < 2; ++ai)
#pragma unroll
                for (int m = 0; m < 4; ++m) { bf16* rp = C + (size_t)(row0 + ai * 128 + m * 16) * 1024 + col0;
#pragma unroll
                    for (int bj = 0; bj < 2; ++bj) *(v4u*)(rp + bj * 128) = fe::pack8(acc[ai][bj][m][0], acc[ai][bj][m][1]); } } };
    Sch S{(const char*)c.at<bf16>(WS_MEMB), (const char*)c.W(0), c.at<bf16>(WS_MEMK), c.at<bf16>(WS_MEMVT), c.G, c.bx}; Ep E{c.at<bf16>(WS_MEMK), c.at<bf16>(WS_MEMVT)};
    fg::gemm_stream<Sch, Ep, false, false>(c.lds, S, E, c.wave);
}
__device__ __forceinline__ void ph_inproj(const Ctx& c, int l) {
    const KP p_ = c.p;
    fe::SchedT S{(const char*)c.at<bf16>(WS_HB), (const char*)c.W(l * LSTRIDE + O_WIN), 2048, 2048, 16, 64, 20, c.G, c.bx};
    fe::EpiIn E{c.ws, p_->in[6] + l * 64, p_->in[7] + l * 64, p_->in[8] + l * 256, p_->in[9] + l * 128};
    fg::gemm_stream<fe::SchedT, fe::EpiIn, false, false>(c.lds, S, E, c.wave);
}
__device__ __forceinline__ void ph_mla(const Ctx& c, int l) {
    float* tab = c.at<float>(WS_TAB);
    fe::SchedMla S{(const char*)c.at<bf16>(WS_CDQ), (const char*)c.at<bf16>(WS_CDKV), (const char*)c.W(l * LSTRIDE + O_WUQ), (const char*)c.W(l * LSTRIDE + O_WUKV), c.G, c.bx};
    fe::EpiMla E{c.at<float>(WS_SSQQ), c.at<float>(WS_SSQKV), tab + 2048, tab + 2560, c.at<bf16>(WS_CQ), c.at<bf16>(WS_CK), c.at<bf16>(WS_CV)};
    fg::gemm_stream<fe::SchedMla, fe::EpiMla, false, true>(c.lds, S, E, c.wave);
}
__device__ __forceinline__ void ph_merge(const Ctx& c, int l) {
    fe::SchedMerge S{(const char*)c.at<bf16>(WS_YA), (const char*)c.at<bf16>(WS_YB), (const char*)c.at<bf16>(WS_YC), (const char*)c.W(l * LSTRIDE + O_WPA), (const char*)c.W(l * LSTRIDE + O_WPB), (const char*)c.W(l * LSTRIDE + O_WPC), c.G, c.bx};
    fe::EpiMerge E{c.at<bf16>(WS_GATES), c.at<bf16>(WS_MERGED)};
    fg::gemm_stream<fe::SchedMerge, fe::EpiMerge, false, true>(c.lds, S, E, c.wave);
}
__device__ __forceinline__ void ph_proj_pre(const Ctx& c, size_t a_off, size_t w_off) {
    fe::SchedT S{(const char*)c.at<bf16>(a_off), (const char*)c.W(w_off), 2048, 2048, 16, 64, 4, c.G, c.bx};
    fe::EpiF32 E{c.at<float>(WS_F), 1024};
    fg::gemm_stream<fe::SchedT, fe::EpiF32, false, false>(c.lds, S, E, c.wave);
}
__device__ __forceinline__ void ph_xq(const Ctx& c, int l) {
    fe::SchedT S{(const char*)c.at<bf16>(WS_HB), (const char*)c.W(l * LSTRIDE + O_WQ), 2048, 2048, 16, 64, 4, c.G, c.bx};
    fe::EpiBf16 E{c.at<bf16>(WS_XQ), 1024, C2_X};
    fg::gemm_stream<fe::SchedT, fe::EpiBf16, false, false>(c.lds, S, E, c.wave);
}
__device__ __forceinline__ void ph_xs(const Ctx& c, int l) {
    fe::SchedXS S{(const char*)c.at<bf16>(WS_XQ), (const char*)(c.at<bf16>(WS_MEMK) + (size_t)l * 1024 * 1024), c.G, c.bx};
    fe::EpiXS E{c.at<bf16>(WS_MERGED)};
    fg::gemm_stream<fe::SchedXS, fe::EpiXS, false, false>(c.lds, S, E, c.wave);
}
__device__ __forceinline__ void ph_xo(const Ctx& c, int l) {
    fe::SchedXO S{(const char*)c.at<bf16>(WS_MERGED), (const char*)(c.at<bf16>(WS_MEMVT) + (size_t)l * 1024 * 1024), c.G, c.bx};
    fe::EpiBf16 E{c.at<bf16>(WS_XO), 1024, 1.f};
    fg::gemm_stream<fe::SchedXO, fe::EpiBf16, false, false>(c.lds, S, E, c.wave);
}
__device__ __forceinline__ void ph_ffn1(const Ctx& c, int i) {
    fe::SchedT S{(const char*)c.at<bf16>(WS_HB), (const char*)c.W(W_FFN + i * FSTRIDE + O_GU), 2048, 2048, 16, 64, 22, c.G, c.bx};
    fe::EpiGated E{c.at<bf16>(WS_ACT)};
    fg::gemm_stream<fe::SchedT, fe::EpiGated, false, false>(c.lds, S, E, c.wave);
}
__device__ __forceinline__ void ph_ffn2(const Ctx& c, int i) {
    fe::SchedT S{(const char*)c.at<bf16>(WS_ACT), (const char*)c.W(W_FFN + i * FSTRIDE + O_DOWN), 5632, 5632, 44, 64, 4, c.G, c.bx};
    fe::EpiF32 E{c.at<float>(WS_F), 1024};
    fg::gemm_stream<fe::SchedT, fe::EpiF32, false, false>(c.lds, S, E, c.wave);
}
__device__ __forceinline__ void ph_moe1(const Ctx& c, int i) {
    fe::SchedMoe S{(const char*)c.at<bf16>(WS_HB), (const char*)c.W(W_MOE + (size_t)i * 8 * FSTRIDE + O_GU), FSTRIDE * 2, 2048, 2048, 16, 22, c.at<int>(WS_ROUTE + 384 * 1024), c.at<int>(WS_ROUTE + 704 * 1024), c.at<int>(WS_ROUTE + 705 * 1024), c.G, c.bx, true};
    fe::EpiGated E{c.at<bf16>(WS_ACT)};
    fg::gemm_stream<fe::SchedMoe, fe::EpiGated, true, true>(c.lds, S, E, c.wave);
}
__device__ __forceinline__ void ph_moe2(const Ctx& c, int i) {
    fe::SchedMoe S{(const char*)c.at<bf16>(WS_ACT), (const char*)c.W(W_MOE + (size_t)i * 8 * FSTRIDE + O_DOWN), FSTRIDE * 2, 5632, 5632, 44, 4, c.at<int>(WS_ROUTE + 384 * 1024), c.at<int>(WS_ROUTE + 704 * 1024), c.at<int>(WS_ROUTE + 705 * 1024), c.G, c.bx, false};
    fe::EpiF32 E{c.at<float>(WS_Y), 1024};
    fg::gemm_stream<fe::SchedMoe, fe::EpiF32, false, false>(c.lds, S, E, c.wave);
}
__device__ __forceinline__ void ph_attn(const Ctx& c, int l, int which  ) {
    const KP p_ = c.p; const int wid = c.wave;
    if (which & 2) {
        for (int k = 0; k < 2; ++k) { const int u = c.vcu * 2 + k; if (u >= 512) break; const int bh = u >> 4, b = bh >> 3, hq = bh & 7, qb = u & 15; const size_t qrow = (size_t)b * SEQ + qb * 256 + 32 * wid;
            fa::AttnArgs a{}; a.Qw = c.at<bf16>(WS_BQ) + qrow * 512 + hq * 64; a.pitchQ = 512; a.K1 = c.at<bf16>(WS_BK) + (size_t)b * SEQ * 128 + (hq >> 2) * 64; a.pitchK1 = 128; a.K2 = nullptr; a.pitchK2 = 0;
            a.V = c.at<bf16>(WS_BV) + (size_t)b * SEQ * 128 + (hq >> 2) * 64; a.pitchV = 128; a.Ow = c.at<bf16>(WS_YB) + qrow * 512 + hq * 64; a.pitchO = 512; a.NT = 64;
            fa::attn_unit<64, 0, 64, false>(c.lds, a, c.wave); }
    }
    if (which & 4) {
        const int u = c.vcu; if (u < 256) { const int b = u >> 6, h = (u >> 4) & 3, qb = u & 15; const size_t qrow = (size_t)b * SEQ + qb * 256 + 32 * wid;
            fa::AttnArgs a{}; a.Qw = c.at<bf16>(WS_CQ) + qrow * 384 + h * 96; a.pitchQ = 384; a.K1 = c.at<bf16>(WS_CK) + (size_t)b * SEQ * 256 + h * 64; a.pitchK1 = 256; a.K2 = c.at<bf16>(WS_KPE) + (size_t)b * SEQ * 32; a.pitchK2 = 32;
            a.V = c.at<bf16>(WS_CV) + (size_t)b * SEQ * 256 + h * 64; a.pitchV = 256; a.Ow = c.at<bf16>(WS_YC) + qrow * 256 + h * 64; a.pitchO = 256; a.NT = 64;
            fa::attn_unit<64, 32, 64, false>(c.lds, a, c.wave); }
    }
    if (which & 1) {
        const int u = c.vcu; if (u < 256) { const int b = u >> 6, h = (u >> 4) & 3, R0 = 4 * (u & 15);
            LAS float* rpbs = (LAS float*)(c.lds + EPI_OFF); const float* rpb = p_->in[5] + (size_t)(l * 4 + h) * 15 * 31;
            { const int tid_ = otid(c.wave); if (tid_ < 480) { const int dr = tid_ >> 5, dc = tid_ & 31; rpbs[tid_] = (dc < 31) ? rpb[dr * 31 + dc] * LOG2E : 0.f; } }
            int krf = R0 - 4; krf = krf < 0 ? 0 : (krf > 56 ? 56 : krf); int krl = R0 + 3 - 4; krl = krl < 0 ? 0 : (krl > 56 ? 56 : krl); krl += 7;
            const int r = R0 + (wid >> 1); int w0 = r - 4; w0 = w0 < 0 ? 0 : (w0 > 56 ? 56 : w0);
            const size_t qrow = (size_t)b * SEQ + r * 64 + 32 * (wid & 1);
            fa::AttnArgs a{}; a.Qw = c.at<bf16>(WS_AQ) + qrow * 256 + h * 64; a.pitchQ = 256; a.K1 = c.at<bf16>(WS_AK) + ((size_t)b * SEQ + krf * 64) * 256 + h * 64; a.pitchK1 = 256; a.K2 = nullptr; a.pitchK2 = 0;
            a.V = c.at<bf16>(WS_AV) + ((size_t)b * SEQ + krf * 64) * 256 + h * 64; a.pitchV = 256; a.Ow = c.at<bf16>(WS_YA) + qrow * 256 + h * 64; a.pitchO = 256; a.NT = krl - krf + 1;
            a.t_lo = w0 - krf; a.t_hi = w0 - krf + 8; a.dr0 = krf - r + 7; a.cq0 = 32 * (wid & 1); a.rpbs = rpbs;
            fa::attn_unit<64, 0, 64, true>(c.lds, a, c.wave); }
    }
}

__device__ __forceinline__ Ctx make_ctx(unsigned char* lds) {
    Ctx c; c.lds = (LAS unsigned char*)lds; c.wave = __builtin_amdgcn_readfirstlane((int)threadIdx.x >> 6); c.G = gridDim.x; c.bx = blockIdx.x;
    c.vcu = (c.G % 8 == 0) ? (c.bx % 8) * (c.G / 8) + c.bx / 8 : c.bx; c.p = kargs(); c.ws = c.p->ws; return c;
}
template <int PH> __device__ __forceinline__ void run_phase(const Ctx& c, int l) {
    const KP p_ = c.p; const int i = l >> 1;
    if constexpr (PH == 0) ph_convert(c);
    else if constexpr (PH == 1) ph_ln(c, 0, p_->in[2], p_->in[3], false, nullptr, false);
    else if constexpr (PH == 2) ph_memkv(c);
    else if constexpr (PH == 3) ph_inproj(c, l);
    else if constexpr (PH == 4) ph_mla(c, l);
    else if constexpr (PH == 5) ph_attn(c, l, 7);
    else if constexpr (PH == 6) ph_merge(c, l);
    else if constexpr (PH == 7) ph_proj_pre(c, WS_MERGED, l * LSTRIDE + O_WOUT);
    else if constexpr (PH == 8) ph_ln(c, 1, p_->in[19] + (size_t)(l * 3 + 0) * D, p_->in[20] + (size_t)(l * 3 + 0) * D, false, nullptr, false);
    else if constexpr (PH == 9) ph_xq(c, l);
    else if constexpr (PH == 10) ph_xs(c, l);
    else if constexpr (PH == 11) ph_xo(c, l);
    else if constexpr (PH == 12) ph_proj_pre(c, WS_XO, l * LSTRIDE + O_WO);
    else if constexpr (PH == 13) ph_ln(c, 1, p_->in[19] + (size_t)(l * 3 + 1) * D, p_->in[20] + (size_t)(l * 3 + 1) * D, (l & 1) != 0, p_->in[23] + (size_t)i * D * NE, false);
    else if constexpr (PH == 14) ph_ffn1(c, i);
    else if constexpr (PH == 15) ph_ffn2(c, i);
    else if constexpr (PH == 16) ph_ln(c, 1, p_->in[19] + (size_t)(l * 3 + 2) * D, p_->in[20] + (size_t)(l * 3 + 2) * D, false, nullptr, l == DEPTH - 1);
    else if constexpr (PH == 17) ph_moe_count(c);
    else if constexpr (PH == 18) ph_moe_assign(c);
    else if constexpr (PH == 19) ph_moe1(c, i);
    else if constexpr (PH == 20) ph_moe2(c, i);
    else if constexpr (PH == 21) ph_ln(c, 2, p_->in[19] + (size_t)(l * 3 + 2) * D, p_->in[20] + (size_t)(l * 3 + 2) * D, false, nullptr, l == DEPTH - 1);
}
template <int PH> __global__ void __launch_bounds__(NWAVES * 64, 2) k_fast(FP p) {
    extern __shared__ __attribute__((aligned(16))) unsigned char lds[];
    const Ctx c = make_ctx(lds);
    run_phase<PH>(c, c.p->l);
}

constexpr int CW_BAR = 4096;
__global__ void __launch_bounds__(NWAVES * 64, 2) k_mega(FP p) {
    extern __shared__ __attribute__((aligned(16))) unsigned char lds[];
    const Ctx c = make_ctx(lds);
    for (int u = threadIdx.x; u < 64; u += NWAVES * 64) ((LAS unsigned*)((LAS unsigned char*)lds + MISC_OFF))[u] = 0u;
    __syncthreads();
    const XcdBarrier bar = xcd_barrier_post((unsigned*)(c.ws + WS_CTL) + CW_BAR, (volatile LAS unsigned*)((LAS unsigned char*)lds + MISC_OFF) + 8);
#define GB() xcd_barrier(bar)
    ph_convert(fresh(c)); GB();
    { const Ctx f = fresh(c); ph_ln(f, 0, f.p->in[2], f.p->in[3], false, nullptr, false); }
    ph_memkv(fresh(c)); GB();
    for (int l = 0; l < DEPTH; ++l) {
        const int i = l >> 1; const bool odd = (l & 1) != 0;
        ph_inproj(fresh(c), l); GB();
        ph_mla(fresh(c), l); GB();
        ph_attn(fresh(c), l, 7); GB();
        ph_merge(fresh(c), l); GB();
        ph_proj_pre(fresh(c), WS_MERGED, l * LSTRIDE + O_WOUT); GB();
        { const Ctx f = fresh(c); ph_ln(f, 1, f.p->in[19] + (size_t)(l * 3) * D, f.p->in[20] + (size_t)(l * 3) * D, false, nullptr, false); } GB();
        ph_xq(fresh(c), l); GB();
        ph_xs(fresh(c), l); GB();
        ph_xo(fresh(c), l); GB();
        ph_proj_pre(fresh(c), WS_XO, l * LSTRIDE + O_WO); GB();
        { const Ctx f = fresh(c); ph_ln(f, 1, f.p->in[19] + (size_t)(l * 3 + 1) * D, f.p->in[20] + (size_t)(l * 3 + 1) * D, odd, f.p->in[23] + (size_t)i * D * NE, false); } GB();
        if (!odd) { ph_ffn1(fresh(c), i); GB(); ph_ffn2(fresh(c), i); GB(); }
        else { ph_moe_count(fresh(c)); GB(); ph_moe_assign(fresh(c)); GB(); ph_moe1(fresh(c), i); GB(); ph_moe2(fresh(c), i); GB(); }
        { const Ctx f = fresh(c); ph_ln(f, odd ? 2 : 1, f.p->in[19] + (size_t)(l * 3 + 2) * D, f.p->in[20] + (size_t)(l * 3 + 2) * D, false, nullptr, l == DEPTH - 1); }
        if (l + 1 < DEPTH) GB();
    }
#undef GB
}
extern "C" void kernel_launch(void* const* d_in, const int* in_sizes, int n_in, void* d_out, int out_size, void* d_ws, size_t ws_size, hipStream_t stream) {
    if (n_in != 26 || out_size != T * D || ws_size < WS_END) { fprintf(stderr, "kernel_launch: unexpected shapes (n_in %d out %d ws %zu)\n", n_in, out_size, ws_size); return; }
    static int grid = 0;
    if (grid == 0) {
        int dev = 0, cus = 0, per_cu = 0;
        if (hipGetDevice(&dev) != hipSuccess || hipDeviceGetAttribute(&cus, hipDeviceAttributeMultiprocessorCount, dev) != hipSuccess) { fprintf(stderr, "kernel_launch: device query failed\n"); grid = -1; return; }
        if (hipFuncSetAttribute((const void*)k_mega, hipFuncAttributeMaxDynamicSharedMemorySize, LDS_BYTES) != hipSuccess) { fprintf(stderr, "kernel_launch: hipFuncSetAttribute failed\n"); grid = -1; return; }
        if (hipOccupancyMaxActiveBlocksPerMultiprocessor(&per_cu, (const void*)k_mega, NWAVES * 64, LDS_BYTES) != hipSuccess || per_cu < 1) fprintf(stderr, "kernel_launch: occupancy query says %d per CU\n", per_cu);
        (void)hipGetLastError();
        grid = cus;
        if (grid != 256) fprintf(stderr, "kernel_launch: %d CUs (built for 256)\n", grid);
    }
    if (grid < 0) return;
    (void)hipMemsetAsync((char*)d_ws + WS_CTL, 0, CTL_ZERO_BYTES, stream);
    FP fp{}; for (int i = 0; i < 26; ++i) fp.in[i] = (const float*)d_in[i]; fp.out = (float*)d_out; fp.ws = (unsigned char*)d_ws; fp.l = 0; fp.pad = 0;
    hipLaunchKernelGGL(k_mega, dim3(grid), dim3(NWAVES * 64), LDS_BYTES, stream, fp);
}
```
